# Optimizing an MI355X kernel written in HIP

```python
import jax
import jax.numpy as jnp
from jax import lax
import numpy as np

D_MODEL = 1024
BATCH = 2
SEQ = 8192
DEPTH = 2

N_BRANCH = 3
A_WIDTH = D_MODEL
A_GROUPS = 4
A_CHUNK = 128
B_HEADS = 8
B_HEAD_DIM = 64
B_WIDTH = B_HEADS * B_HEAD_DIM
Q_BLOCK = 128
C_HEADS = 8
C_HEAD_DIM = 64
C_WIDTH = C_HEADS * C_HEAD_DIM
C_DECAY_LORA = 64
C_AAA_LORA = 64
C_MV_LORA = 32
C_GATE_LORA = 128
C_GN_EPS = 64e-5
D_FF = ((8 * D_MODEL // 3 + 255) // 256) * 256

A_COLS = 2 * A_WIDTH
B_COLS = 3 * B_WIDTH + B_HEADS
C_COLS = 3 * C_WIDTH + C_DECAY_LORA + C_AAA_LORA + C_GATE_LORA
G_COLS = N_BRANCH * D_MODEL
IN_COLS = A_COLS + B_COLS + C_COLS + G_COLS
IN_SPLITS = (A_COLS, A_COLS + B_COLS, A_COLS + B_COLS + C_COLS)
B_SPLITS = (B_WIDTH, 2 * B_WIDTH, 3 * B_WIDTH)
C_SPLITS = (C_WIDTH, 2 * C_WIDTH, 3 * C_WIDTH, 3 * C_WIDTH + C_DECAY_LORA,
            3 * C_WIDTH + C_DECAY_LORA + C_AAA_LORA)
NORM_EPS = 1e-6
LN_EPS = 1e-5

kernel_name = 'hybrid_gated_gmlp_fox_rwkv7'


def rmsnorm(x, g):
    xf = x.astype(jnp.float32)
    y = xf * lax.rsqrt(jnp.mean(xf * xf, axis=-1, keepdims=True) + NORM_EPS)
    return (y * g.astype(jnp.float32)).astype(x.dtype)


def layernorm(x, g, b):
    xf = x.astype(jnp.float32)
    mu = jnp.mean(xf, axis=-1, keepdims=True)
    var = jnp.mean(jnp.square(xf - mu), axis=-1, keepdims=True)
    y = (xf - mu) * lax.rsqrt(var + LN_EPS)
    return (y * g.astype(jnp.float32) + b.astype(jnp.float32)).astype(x.dtype)


def token_shift(p):
    return jnp.pad(p, ((0, 0), (1, 0), (0, 0)))[:, :-1]


def spatial_gating_unit(u, v, ln_g, ln_b, w_s, b_s):
    bn, s, _ = v.shape
    n_chunks = s // A_CHUNK
    gd = A_WIDTH // A_GROUPS
    v = layernorm(v, ln_g, ln_b)
    causal = jnp.tril(jnp.ones((A_CHUNK, A_CHUNK), dtype=bool))
    w = jnp.where(causal[None], w_s, jnp.zeros_like(w_s)).astype(v.dtype)
    vc = v.reshape(bn, n_chunks, A_CHUNK, A_GROUPS, gd)
    mixed = jnp.einsum('gts,bcsgd->bctgd', w, vc) + b_s.T.astype(v.dtype)[None, None, :, :, None]
    return u * mixed.reshape(bn, s, A_WIDTH)


def forgetting_attention(q, k, v, f_logit, b_f):
    bn, s = q.shape[:2]
    n_blocks = s // Q_BLOCK
    log_f = jax.nn.log_sigmoid((f_logit + b_f).astype(jnp.float32))
    c = jnp.cumsum(log_f, axis=1)
    c_keys = c.transpose(0, 2, 1)
    kf = k.astype(jnp.float32)
    vf = v.astype(jnp.float32)
    key_pos = jnp.arange(s)
    qb = (q.astype(jnp.float32) * B_HEAD_DIM ** -0.5).reshape(
        bn, n_blocks, Q_BLOCK, B_HEADS, B_HEAD_DIM).swapaxes(0, 1)
    cb = c.reshape(bn, n_blocks, Q_BLOCK, B_HEADS).swapaxes(0, 1)

    def query_block(args):
        i, q_i, c_i = args
        logits = jnp.einsum('bqhd,bkhd->bhqk', q_i, kf)
        logits = logits + (c_i.transpose(0, 2, 1)[..., :, None] - c_keys[:, :, None, :])
        q_pos = i * Q_BLOCK + jnp.arange(Q_BLOCK)
        mask = key_pos[None, :] <= q_pos[:, None]
        logits = jnp.where(mask, logits, -jnp.inf)
        p = jax.nn.softmax(logits, axis=-1)
        return jnp.einsum('bhqk,bkhd->bqhd', p, vf)

    out = lax.map(query_block, (jnp.arange(n_blocks), qb, cb))
    return out.swapaxes(0, 1).reshape(bn, s, B_WIDTH).astype(q.dtype)


def rwkv7_time_mix(r, k, v, w_lo, a_lo, g_lo, w0, w_up, a0, a_up, g_up,
                   k_k, k_a, r_k, lnx_g, lnx_b):
    bn, s, _ = r.shape
    f32 = jnp.float32
    w = -jax.nn.softplus(-(w0 + jnp.tanh(w_lo) @ w_up).astype(f32)) - 0.5
    decay = jnp.exp(-jnp.exp(w))
    a = jax.nn.sigmoid((a0 + a_lo @ a_up).astype(f32))
    g = (jax.nn.sigmoid(g_lo) @ g_up).astype(f32)
    kk = (k * k_k).astype(f32).reshape(bn, s, C_HEADS, C_HEAD_DIM)
    kk = kk / jnp.maximum(jnp.sqrt(jnp.sum(kk * kk, axis=-1, keepdims=True)), 1e-12)
    k = k.astype(f32) * (1.0 + (a - 1.0) * k_a.astype(f32))

    def heads(t):
        return t.astype(f32).reshape(bn, s, C_HEADS, C_HEAD_DIM)

    rh, kh, vh, ah, dh = heads(r), heads(k), heads(v), heads(a), heads(decay)

    def step(state, inp):
        r_t, d_t, k_t, v_t, kk_t, a_t = inp
        sa = jnp.einsum('bhij,bhj->bhi', state, kk_t)
        state = (state * d_t[..., None, :]
                 - sa[..., :, None] * (kk_t * a_t)[..., None, :]
                 + v_t[..., :, None] * k_t[..., None, :])
        y_t = jnp.einsum('bhij,bhj->bhi', state, r_t)
        return state, y_t

    tm = lambda t: t.swapaxes(0, 1)
    s0 = jnp.zeros((bn, C_HEADS, C_HEAD_DIM, C_HEAD_DIM), f32)
    _, y = lax.scan(step, s0, (tm(rh), tm(dh), tm(kh), tm(vh), tm(kk), tm(ah)))
    y = y.swapaxes(0, 1)
    mu = jnp.mean(y, axis=-1, keepdims=True)
    var = jnp.mean(jnp.square(y - mu), axis=-1, keepdims=True)
    y = ((y - mu) * lax.rsqrt(var + C_GN_EPS)).reshape(bn, s, C_WIDTH)
    y = y * lnx_g.astype(f32) + lnx_b.astype(f32)
    bonus = jnp.sum(rh * kh * r_k.astype(f32), axis=-1, keepdims=True) * vh
    y = y + bonus.reshape(bn, s, C_WIDTH)
    return (y * g).astype(r.dtype)


def setup_inputs(seed: int = 0) -> dict:
    key = jax.random.key(seed)
    keys = list(jax.random.split(key, 40))
    f32 = jnp.float32

    def nrm(shape, scale):
        return scale * jax.random.normal(keys.pop(), shape, f32)

    def unif(shape, lo, hi):
        return jax.random.uniform(keys.pop(), shape, f32, lo, hi)

    L = DEPTH
    Lv = DEPTH - 1
    return {
        'x': nrm((BATCH, SEQ, D_MODEL), 1.0),
        'norm_mix': 1.0 + nrm((L, D_MODEL), 0.02),
        'w_in': nrm((L, D_MODEL, IN_COLS), D_MODEL ** -0.5),
        'gate_bias': nrm((L, N_BRANCH, D_MODEL), 0.02),
        'a_ln_g': 1.0 + nrm((L, A_WIDTH), 0.02),
        'a_ln_b': nrm((L, A_WIDTH), 0.02),
        'a_w_s': nrm((L, A_GROUPS, A_CHUNK, A_CHUNK), A_CHUNK ** -0.5),
        'a_b_s': 1.0 + nrm((L, A_GROUPS, A_CHUNK), 0.1),
        'b_f_bias': unif((L, B_HEADS), 1.0, 5.0),
        'c_mu': unif((L, C_COLS), 0.0, 1.0),
        'c_w0': unif((L, C_WIDTH), -3.0, 1.0),
        'c_w_up': nrm((L, C_DECAY_LORA, C_WIDTH), 0.1),
        'c_a0': nrm((L, C_WIDTH), 0.1),
        'c_a_up': nrm((L, C_AAA_LORA, C_WIDTH), C_AAA_LORA ** -0.5),
        'c_g_up': nrm((L, C_GATE_LORA, C_WIDTH), C_GATE_LORA ** -0.5),
        'c_k_k': 0.85 + nrm((L, C_WIDTH), 0.02),
        'c_k_a': 1.0 + nrm((L, C_WIDTH), 0.02),
        'c_r_k': nrm((L, C_HEADS, C_HEAD_DIM), 0.1),
        'c_lnx_g': 1.0 + nrm((L, C_WIDTH), 0.02),
        'c_lnx_b': nrm((L, C_WIDTH), 0.02),
        'c_v0': nrm((Lv, C_WIDTH), 0.1),
        'c_v_down': nrm((Lv, C_WIDTH, C_MV_LORA), C_WIDTH ** -0.5),
        'c_v_up': nrm((Lv, C_MV_LORA, C_WIDTH), C_MV_LORA ** -0.5),
        'p_a': nrm((L, A_WIDTH, D_MODEL), A_WIDTH ** -0.5),
        'p_b': nrm((L, B_WIDTH, D_MODEL), B_WIDTH ** -0.5),
        'p_c': nrm((L, C_WIDTH, D_MODEL), C_WIDTH ** -0.5),
        'w_out': nrm((L, D_MODEL, D_MODEL), D_MODEL ** -0.5),
        'norm_ffn': 1.0 + nrm((L, D_MODEL), 0.02),
        'w_gate_up': nrm((L, D_MODEL, 2 * D_FF), D_MODEL ** -0.5),
        'w_down': nrm((L, D_FF, D_MODEL), D_FF ** -0.5),
        'norm_final': 1.0 + nrm((D_MODEL,), 0.02),
    }


def reference(x, norm_mix, w_in, gate_bias, a_ln_g, a_ln_b, a_w_s, a_b_s, b_f_bias,
              c_mu, c_w0, c_w_up, c_a0, c_a_up, c_g_up, c_k_k, c_k_a, c_r_k,
              c_lnx_g, c_lnx_b, c_v0, c_v_down, c_v_up, p_a, p_b, p_c, w_out,
              norm_ffn, w_gate_up, w_down, norm_final):
    bn, s, _ = x.shape
    v_first = None
    for l in range(DEPTH):
        h = rmsnorm(x, norm_mix[l])
        proj = h @ w_in[l]
        pa, pb, pc, pg = jnp.split(proj, IN_SPLITS, axis=-1)

        ua, va = jnp.split(jax.nn.gelu(pa), 2, axis=-1)
        ya = spatial_gating_unit(ua, va, a_ln_g[l], a_ln_b[l], a_w_s[l], a_b_s[l])

        qb, kb, vb, fb = jnp.split(pb, B_SPLITS, axis=-1)
        hd = (bn, s, B_HEADS, B_HEAD_DIM)
        yb = forgetting_attention(qb.reshape(hd), kb.reshape(hd), vb.reshape(hd), fb, b_f_bias[l])

        pc = pc + (token_shift(pc) - pc) * c_mu[l]
        rc, kc, vc, wlo, alo, glo = jnp.split(pc, C_SPLITS, axis=-1)
        if l == 0:
            v_first = vc
        else:
            vc = vc + (v_first - vc) * jax.nn.sigmoid(c_v0[l - 1] + (vc @ c_v_down[l - 1]) @ c_v_up[l - 1])
        yc = rwkv7_time_mix(rc, kc, vc, wlo, alo, glo, c_w0[l], c_w_up[l], c_a0[l], c_a_up[l],
                            c_g_up[l], c_k_k[l], c_k_a[l], c_r_k[l], c_lnx_g[l], c_lnx_b[l])

        gates = jax.nn.sigmoid(pg.reshape(bn, s, N_BRANCH, D_MODEL) + gate_bias[l])
        merged = (gates[:, :, 0] * (ya @ p_a[l])
                  + gates[:, :, 1] * (yb @ p_b[l])
                  + gates[:, :, 2] * (yc @ p_c[l]))
        x = x + merged @ w_out[l]

        h = rmsnorm(x, norm_ffn[l])
        gt, up = jnp.split(h @ w_gate_up[l], 2, axis=-1)
        x = x + (jax.nn.silu(gt) * up) @ w_down[l]
    return rmsnorm(x, norm_final)
```

```cpp
#include <hip/hip_runtime.h>
#include <hip/hip_cooperative_groups.h>
#include <cstdio>
namespace cg = cooperative_groups;

#ifndef COOP
#define COOP 1
#endif

typedef unsigned short u16;
typedef unsigned int u32;
using bf16x8 = __attribute__((ext_vector_type(8))) short;
using f32x16 = __attribute__((ext_vector_type(16))) float;

constexpr int T = 16384;
constexpr int S = 8192;
constexpr int DM = 1024;
constexpr int IN_COLS = 8456;
constexpr int NPAD_IN = 8576;
constexpr int NMIX = 5504;
constexpr int DFF = 2816;
constexpr int NTHR = 512;

constexpr size_t U = 16777216;
constexpr size_t R_H = 0;
constexpr size_t R_UA = 2 * U;
constexpr size_t R_VA = 4 * U;
constexpr size_t R_Q = 6 * U;
constexpr size_t R_K = 7 * U;
constexpr size_t R_V = 8 * U;
constexpr size_t R_PC = 9 * U;
constexpr size_t R_LOGF = 12 * U + U / 2;
constexpr size_t R_CUM = R_LOGF + 524288;
constexpr size_t R_W = R_CUM + 524288;
constexpr size_t R_YB = 0;
constexpr size_t RW_R = 6 * U, RW_W = U, RW_K = 4 * U, RW_V = 5 * U, RW_A = 7 * U, RW_G = 8 * U;
constexpr size_t R_YC = U, R_H2 = 10 * U, R_MERGED = 7 * U;
constexpr size_t R_HF = 2 * U, R_ACT = 4 * U;
constexpr size_t WO_IN = 0;
constexpr size_t WO_PA = WO_IN + (size_t)NPAD_IN * 1024;
constexpr size_t WO_PB = WO_PA + 1024 * 1024;
constexpr size_t WO_PC = WO_PB + 1024 * 512;
constexpr size_t WO_OUT = WO_PC + 1024 * 512;
constexpr size_t WO_GU = WO_OUT + 1024 * 1024;
constexpr size_t WO_DN = WO_GU + (size_t)5632 * 1024;
constexpr size_t WO_WUP = WO_DN + (size_t)1024 * 2816;
constexpr size_t WO_AUP = WO_WUP + 512 * 64;
constexpr size_t WO_GUP = WO_AUP + 512 * 64;
constexpr size_t WO_VDN = WO_GUP + 512 * 128;
constexpr size_t WO_VUP = WO_VDN + 32 * 512;
constexpr size_t WO_END = WO_VUP + 512 * 64;
constexpr size_t R_VF = R_W + WO_END * 2;
constexpr size_t WS_CTR = R_VF + U;
constexpr size_t WS_END = WS_CTR + 16384;

constexpr int LDS_BYTES = 147456;

struct Params {
  const float* in[31];
  float* out;
  unsigned char* ws;
  unsigned long long code[4];
  int nph, pad;
};

enum { I_X = 0, I_NORM_MIX, I_W_IN, I_GATE_BIAS, I_A_LN_G, I_A_LN_B, I_A_W_S, I_A_B_S, I_B_F_BIAS, I_C_MU, I_C_W0, I_C_W_UP,
       I_C_A0, I_C_A_UP, I_C_G_UP, I_C_K_K, I_C_K_A, I_C_R_K, I_C_LNX_G, I_C_LNX_B, I_C_V0, I_C_V_DOWN, I_C_V_UP, I_P_A, I_P_B,
       I_P_C, I_W_OUT, I_NORM_FFN, I_W_GATE_UP, I_W_DOWN, I_NORM_FINAL };

__device__ __forceinline__ int opaque_tid() { int t = (int)__builtin_amdgcn_workitem_id_x(); asm volatile("" : "+v"(t)); return t; }
typedef __bf16 bf16x2_t __attribute__((ext_vector_type(2)));
typedef float f32x2_t __attribute__((ext_vector_type(2)));
__device__ __forceinline__ u32 pk2(float a, float b) {
  f32x2_t v = {a, b};
  return __builtin_bit_cast(u32, __builtin_convertvector(v, bf16x2_t));
}
__device__ __forceinline__ u16 f2bf(float f) { return (u16)(pk2(f, 0.f) & 0xffffu); }
__device__ __forceinline__ float bf2f(u16 h) { return __uint_as_float(((u32)h) << 16); }
__device__ __forceinline__ float bflo(u32 w) { return __uint_as_float(w << 16); }
__device__ __forceinline__ float bfhi(u32 w) { return __uint_as_float(w & 0xffff0000u); }
__device__ __forceinline__ float sigmoidf_(float x) { return __builtin_amdgcn_rcpf(1.f + __expf(-x)); }
__device__ __forceinline__ float gelu_tanh(float x) {
  float u = 0.7978845608028654f * (x + 0.044715f * x * x * x);
  return x * __builtin_amdgcn_rcpf(1.f + __expf(-2.f * u));
}
__device__ __forceinline__ float softplusf_(float x) { return fmaxf(x, 0.f) + __logf(1.f + __expf(-fabsf(x))); }
__device__ __forceinline__ float wave_sum(float v) {
#pragma unroll
  for (int o = 1; o < 64; o <<= 1) v += __shfl_xor(v, o);
  return v;
}
__device__ __forceinline__ float row16_sum(float v) {
  v += __int_as_float(__builtin_amdgcn_update_dpp(0, __float_as_int(v), 0xB1, 0xF, 0xF, false));
  v += __int_as_float(__builtin_amdgcn_update_dpp(0, __float_as_int(v), 0x4E, 0xF, 0xF, false));
  v += __int_as_float(__builtin_amdgcn_update_dpp(0, __float_as_int(v), 0x141, 0xF, 0xF, false));
  v += __int_as_float(__builtin_amdgcn_update_dpp(0, __float_as_int(v), 0x140, 0xF, 0xF, false));
  return v;
}

__device__ __forceinline__ float wave_sum_fast(float v) {
  v = row16_sum(v);
  const float s0 = __int_as_float(__builtin_amdgcn_readlane(__float_as_int(v), 0));
  const float s1 = __int_as_float(__builtin_amdgcn_readlane(__float_as_int(v), 16));
  const float s2 = __int_as_float(__builtin_amdgcn_readlane(__float_as_int(v), 32));
  const float s3 = __int_as_float(__builtin_amdgcn_readlane(__float_as_int(v), 48));
  return (s0 + s1) + (s2 + s3);
}
__device__ __forceinline__ int map_col(int kind, int np) {
  if (kind == 0) return np;
  if (kind == 1) { return np < 3592 ? np : (np < 3712 ? -1 : np - 120); }
  int grp = np >> 6, jj = np & 63;
  return jj < 32 ? 32 * grp + jj : DFF + 32 * grp + (jj - 32);
}
__device__ __forceinline__ void conv_item(const float* W, int K, int Nsrc, int Ndst, int kind, u16* Wt, float* scr, int item, int lane, int Kvalid = 1 << 30) {
  const int nblk = Ndst / 32, kb = item / nblk, nb = item % nblk, k0 = 64 * kb, n0 = 32 * nb;
  const int n = map_col(kind, n0 + (lane & 31));
  float tmpw[32];
#pragma unroll
  for (int i = 0; i < 32; ++i) {
    const int kk = 2 * i + (lane >> 5);
    tmpw[i] = (n >= 0 && k0 + kk < Kvalid) ? W[(size_t)(k0 + kk) * Nsrc + n] : 0.f;
  }
  __builtin_amdgcn_sched_barrier(0);
#pragma unroll
  for (int i = 0; i < 32; ++i) scr[(2 * i + (lane >> 5)) * 33 + (lane & 31)] = tmpw[i];
  __builtin_amdgcn_wave_barrier();
  __builtin_amdgcn_s_waitcnt(0xc07f);
  const int c = lane & 7;
#pragma unroll
  for (int j = 0; j < 4; ++j) {
    const int nn = (lane >> 3) + 8 * j;
    const float* s = scr + (8 * c) * 33 + nn;
    uint4 o;
    o.x = pk2(s[0 * 33], s[1 * 33]); o.y = pk2(s[2 * 33], s[3 * 33]); o.z = pk2(s[4 * 33], s[5 * 33]); o.w = pk2(s[6 * 33], s[7 * 33]);
    *(uint4*)(Wt + (size_t)(n0 + nn) * K + k0 + 8 * c) = o;
  }
  __builtin_amdgcn_wave_barrier();
  __builtin_amdgcn_s_waitcnt(0xc07f);
}

__device__ __forceinline__ void ph_convert(const Params& p, int l, unsigned char* smem, int bid, int nb, int part) {
  const int lane = opaque_tid() & 63, wave = opaque_tid() >> 6;
  float* scr = (float*)smem + wave * (64 * 33);
  u16* Wb = (u16*)(p.ws + R_W);
  const int gw = bid * 8 + wave, ngw = nb * 8;
  constexpr int I0 = 16 * (NPAD_IN / 32), I1 = 16 * 32, I2 = 8 * 32, I3 = 8 * 32, I4 = 16 * 32, I5 = 16 * (5632 / 32), I6 = 44 * 32;
  if (part == 0) {
    constexpr int NA = I0 + I1 + I2 + I3 + I4 + 16 + 16 + 32 + 8 + 16;
    for (int it = gw; it < NA; it += ngw) {
      int r = it;
      if (r < I0) { conv_item(p.in[I_W_IN] + (size_t)l * 1024 * IN_COLS, 1024, IN_COLS, NPAD_IN, 1, Wb + WO_IN, scr, r, lane); continue; } r -= I0;
      if (r < I1) { conv_item(p.in[I_P_A] + (size_t)l * 1024 * 1024, 1024, 1024, 1024, 0, Wb + WO_PA, scr, r, lane); continue; } r -= I1;
      if (r < I2) { conv_item(p.in[I_P_B] + (size_t)l * 512 * 1024, 512, 1024, 1024, 0, Wb + WO_PB, scr, r, lane); continue; } r -= I2;
      if (r < I3) { conv_item(p.in[I_P_C] + (size_t)l * 512 * 1024, 512, 1024, 1024, 0, Wb + WO_PC, scr, r, lane); continue; } r -= I3;
      if (r < I4) { conv_item(p.in[I_W_OUT] + (size_t)l * 1024 * 1024, 1024, 1024, 1024, 0, Wb + WO_OUT, scr, r, lane); continue; } r -= I4;
      if (r < 16) { conv_item(p.in[I_C_W_UP] + (size_t)l * 64 * 512, 64, 512, 512, 0, Wb + WO_WUP, scr, r, lane); continue; } r -= 16;
      if (r < 16) { conv_item(p.in[I_C_A_UP] + (size_t)l * 64 * 512, 64, 512, 512, 0, Wb + WO_AUP, scr, r, lane); continue; } r -= 16;
      if (r < 32) { conv_item(p.in[I_C_G_UP] + (size_t)l * 128 * 512, 128, 512, 512, 0, Wb + WO_GUP, scr, r, lane); continue; } r -= 32;
      if (l == 0) continue;
      if (r < 8) { conv_item(p.in[I_C_V_DOWN] + (size_t)(l - 1) * 512 * 32, 512, 32, 32, 0, Wb + WO_VDN, scr, r, lane); continue; } r -= 8;
      conv_item(p.in[I_C_V_UP] + (size_t)(l - 1) * 32 * 512, 64, 512, 512, 0, Wb + WO_VUP, scr, r, lane, 32);
    }
  } else {
    for (int it = gw; it < I5 + I6; it += ngw) {
      int r = it;
      if (r < I5) { conv_item(p.in[I_W_GATE_UP] + (size_t)l * 1024 * 5632, 1024, 5632, 5632, 2, Wb + WO_GU, scr, r, lane); continue; } r -= I5;
      conv_item(p.in[I_W_DOWN] + (size_t)l * DFF * 1024, DFF, 1024, 1024, 0, Wb + WO_DN, scr, r, lane);
    }
  }
}

__device__ __forceinline__ void ph_rmsnorm(const float* src, const float* g, u16* dst, float* dstf, int widx, int nw) {
  const int lane = opaque_tid() & 63;
  float4 gg[4];
#pragma unroll
  for (int j = 0; j < 4; ++j) gg[j] = *(const float4*)(g + 4 * lane + 256 * j);
  for (int row0 = widx; row0 < T; row0 += 4 * nw) {
    float4 v[4][4];
#pragma unroll
    for (int u = 0; u < 4; ++u) {
      const int row = (row0 + u * nw < T) ? row0 + u * nw : widx;
#pragma unroll
      for (int j = 0; j < 4; ++j) v[u][j] = *(const float4*)(src + (size_t)row * 1024 + 4 * lane + 256 * j);
    }
    __builtin_amdgcn_sched_barrier(0);
#pragma unroll
    for (int u = 0; u < 4; ++u) {
      const int row = row0 + u * nw;
      float s = 0.f;
#pragma unroll
      for (int j = 0; j < 4; ++j) s += (v[u][j].x * v[u][j].x + v[u][j].y * v[u][j].y) + (v[u][j].z * v[u][j].z + v[u][j].w * v[u][j].w);
      s = wave_sum_fast(s);
      const float rs = rsqrtf(s * (1.f / 1024.f) + 1e-6f);
      if (row < T) {
#pragma unroll
        for (int j = 0; j < 4; ++j) {
          const float a = v[u][j].x * rs * gg[j].x, b2 = v[u][j].y * rs * gg[j].y, c = v[u][j].z * rs * gg[j].z, d = v[u][j].w * rs * gg[j].w;
          if (dstf) *(float4*)(dstf + (size_t)row * 1024 + 4 * lane + 256 * j) = make_float4(a, b2, c, d);
          else { uint2 o; o.x = pk2(a, b2); o.y = pk2(c, d); *(uint2*)(dst + (size_t)row * 1024 + 4 * lane + 256 * j) = o; }
        }
      }
    }
  }
}

constexpr int LROW = 72;
constexpr int STAGE_ELEMS = (256 + 128) * LROW;

typedef unsigned int v4u __attribute__((ext_vector_type(4)));
struct GkRegs { v4u a0, a1, a2, a3, b0, b1; };
#define GK_LOAD(R, KT)                                                          \
  {                                                                             \
    const u16* pa_ = A + (size_t)lrow * lda + (KT) * 64 + lkc;                  \
    const u16* pb_ = B + (size_t)lrow * ldb + (KT) * 64 + lkc;                  \
    R.a0 = *(const v4u*)(pa_);                                                \
    R.a1 = *(const v4u*)(pa_ + (size_t)64 * lda);                             \
    R.a2 = *(const v4u*)(pa_ + (size_t)128 * lda);                            \
    R.a3 = *(const v4u*)(pa_ + (size_t)192 * lda);                            \
    R.b0 = *(const v4u*)(pb_);                                                \
    R.b1 = *(const v4u*)(pb_ + (size_t)64 * ldb);                             \
  }
#define GK_WRITE(R, BUF)                                                        \
  {                                                                             \
    u16* wa_ = smem + (BUF) * STAGE_ELEMS + lrow * LROW + lkc;                  \
    u16* wb_ = wa_ + 256 * LROW;                                                \
    *(v4u*)(wa_) = R.a0;                                                      \
    *(v4u*)(wa_ + 64 * LROW) = R.a1;                                          \
    *(v4u*)(wa_ + 128 * LROW) = R.a2;                                         \
    *(v4u*)(wa_ + 192 * LROW) = R.a3;                                         \
    *(v4u*)(wb_) = R.b0;                                                      \
    *(v4u*)(wb_ + 64 * LROW) = R.b1;                                          \
  }
#define GK_COMPUTE(BUF)                                                                                                 \
  {                                                                                                                     \
    const u16* sa_ = smem + (BUF) * STAGE_ELEMS; const u16* sb_ = sa_ + 256 * LROW;                                     \
    _Pragma("unroll") for (int s = 0; s < 4; ++s) {                                                                     \
      bf16x8 af[2], bfr[2];                                                                                             \
      _Pragma("unroll") for (int i = 0; i < 2; ++i) af[i] = *(const bf16x8*)(sa_ + (wm * 64 + i * 32 + r) * LROW + s * 16 + h * 8);  \
      _Pragma("unroll") for (int j = 0; j < 2; ++j) bfr[j] = *(const bf16x8*)(sb_ + (wn * 64 + j * 32 + r) * LROW + s * 16 + h * 8); \
      _Pragma("unroll") for (int i = 0; i < 2; ++i) _Pragma("unroll") for (int j = 0; j < 2; ++j)                       \
        acc[i][j] = __builtin_amdgcn_mfma_f32_32x32x16_bf16(af[i], bfr[j], acc[i][j], 0, 0, 0);                         \
    }                                                                                                                   \
  }
#ifndef GEMM_DMA
#define GEMM_DMA 1
#endif
#if GEMM_DMA
constexpr int DS_A = 256 * 64, DS_STAGE = (256 + 128) * 64;
__device__ __forceinline__ void gd_issue(const u16* __restrict__ A, int lda, const u16* __restrict__ B, int ldb, int kt, int st, u16* smem, int lane, int wave) {
  const int drow = lane >> 3;
  const int rowA = wave * 32 + drow, rowB = wave * 16 + drow;
  const u16* gA0 = A + (size_t)rowA * lda + (((lane & 7) ^ ((rowA >> 1) & 7)) * 8) + kt * 64;
  const u16* gA1 = A + (size_t)(rowA + 8) * lda + (((lane & 7) ^ (((rowA + 8) >> 1) & 7)) * 8) + kt * 64;
  const u16* gB0 = B + (size_t)rowB * ldb + (((lane & 7) ^ ((rowB >> 1) & 7)) * 8) + kt * 64;
  const u16* gB1 = B + (size_t)(rowB + 8) * ldb + (((lane & 7) ^ (((rowB + 8) >> 1) & 7)) * 8) + kt * 64;
  u16* sA_ = smem + st * DS_STAGE + wave * 32 * 64;
  u16* sB_ = smem + st * DS_STAGE + DS_A + wave * 16 * 64;
  __builtin_amdgcn_global_load_lds((const unsigned*)(gA0), (unsigned*)(sA_), 16, 0, 0);
  __builtin_amdgcn_global_load_lds((const unsigned*)(gA1), (unsigned*)(sA_ + 8 * 64), 16, 0, 0);
  __builtin_amdgcn_global_load_lds((const unsigned*)(gA0 + (size_t)16 * lda), (unsigned*)(sA_ + 16 * 64), 16, 0, 0);
  __builtin_amdgcn_global_load_lds((const unsigned*)(gA1 + (size_t)16 * lda), (unsigned*)(sA_ + 24 * 64), 16, 0, 0);
  __builtin_amdgcn_global_load_lds((const unsigned*)(gB0), (unsigned*)(sB_), 16, 0, 0);
  __builtin_amdgcn_global_load_lds((const unsigned*)(gB1), (unsigned*)(sB_ + 8 * 64), 16, 0, 0);
}
__device__ __forceinline__ void gemm_prefetch(const u16* __restrict__ A, int lda, const u16* __restrict__ B, int ldb, int K, u16* smem) {
  const int tid = opaque_tid(), lane = tid & 63, wave = __builtin_amdgcn_readfirstlane(tid >> 6);
  gd_issue(A, lda, B, ldb, 0, 0, smem, lane, wave);
  gd_issue(A, lda, B, ldb, (K > 64 ? 1 : 0), 1, smem, lane, wave);
}
__device__ __forceinline__ void gemm_kloop(const u16* __restrict__ A, int lda, const u16* __restrict__ B, int ldb, int K,
                                           f32x16 (&acc)[2][2], u16* smem, bool prefetched = false, bool pipe = true) {
  const int tid = opaque_tid(), lane = tid & 63, wave = __builtin_amdgcn_readfirstlane(tid >> 6);
  const int wm = wave >> 1, wn = wave & 1, r = lane & 31, h = lane >> 5;
  const int nk = K >> 6;
  const int key = (r >> 1) & 7;
  if (!prefetched) {
    gd_issue(A, lda, B, ldb, 0, 0, smem, lane, wave);
    gd_issue(A, lda, B, ldb, (nk > 1 ? 1 : 0), 1, smem, lane, wave);
  }
  int st = 0;
  for (int kt = 0; kt < nk; ++kt) {
    __builtin_amdgcn_sched_barrier(0);
    if (kt + 1 < nk) asm volatile("s_waitcnt vmcnt(6)" ::: "memory"); else asm volatile("s_waitcnt vmcnt(0)" ::: "memory");
    __builtin_amdgcn_s_barrier();
    __builtin_amdgcn_sched_barrier(0);
    if (kt + 2 < nk) {
      const int st2 = (st >= 1) ? st - 1 : 2;
      gd_issue(A, lda, B, ldb, kt + 2, st2, smem, lane, wave);
    }
    const u16* sa_ = smem + st * DS_STAGE + (wm * 64 + r) * 64;
    const u16* sb_ = smem + st * DS_STAGE + DS_A + (wn * 64 + r) * 64;
    if (pipe) {
    bf16x8 af[2][2], bfr[2][2];
    {
      const int co = ((0 + h) ^ key) * 8;
#pragma unroll
      for (int i = 0; i < 2; ++i) af[0][i] = *(const bf16x8*)(sa_ + i * 32 * 64 + co);
#pragma unroll
      for (int j = 0; j < 2; ++j) bfr[0][j] = *(const bf16x8*)(sb_ + j * 32 * 64 + co);
    }
#pragma unroll
    for (int s4 = 0; s4 < 4; ++s4) {
      if (s4 < 3) {
        const int co = ((2 * (s4 + 1) + h) ^ key) * 8;
#pragma unroll
        for (int i = 0; i < 2; ++i) af[(s4 + 1) & 1][i] = *(const bf16x8*)(sa_ + i * 32 * 64 + co);
#pragma unroll
        for (int j = 0; j < 2; ++j) bfr[(s4 + 1) & 1][j] = *(const bf16x8*)(sb_ + j * 32 * 64 + co);
      }
#pragma unroll
      for (int i = 0; i < 2; ++i)
#pragma unroll
        for (int j = 0; j < 2; ++j) acc[i][j] = __builtin_amdgcn_mfma_f32_32x32x16_bf16(af[s4 & 1][i], bfr[s4 & 1][j], acc[i][j], 0, 0, 0);
    }
    __builtin_amdgcn_sched_group_barrier(0x100, 8, 0);
    __builtin_amdgcn_sched_group_barrier(0x008, 4, 0);
    __builtin_amdgcn_sched_group_barrier(0x100, 4, 0);
    __builtin_amdgcn_sched_group_barrier(0x008, 4, 0);
    __builtin_amdgcn_sched_group_barrier(0x100, 4, 0);
    __builtin_amdgcn_sched_group_barrier(0x008, 8, 0);
    } else {
#pragma unroll
      for (int s4 = 0; s4 < 4; ++s4) {
        const int co = ((2 * s4 + h) ^ key) * 8;
        bf16x8 af1[2], bfr1[2];
#pragma unroll
        for (int i = 0; i < 2; ++i) af1[i] = *(const bf16x8*)(sa_ + i * 32 * 64 + co);
#pragma unroll
        for (int j = 0; j < 2; ++j) bfr1[j] = *(const bf16x8*)(sb_ + j * 32 * 64 + co);
#pragma unroll
        for (int i = 0; i < 2; ++i)
#pragma unroll
          for (int j = 0; j < 2; ++j) acc[i][j] = __builtin_amdgcn_mfma_f32_32x32x16_bf16(af1[i], bfr1[j], acc[i][j], 0, 0, 0);
      }
    }
    st = (st == 2) ? 0 : st + 1;
  }
  asm volatile("s_waitcnt lgkmcnt(0)" ::: "memory");
  __builtin_amdgcn_s_barrier();
}
#else
__device__ __forceinline__ void gemm_kloop(const u16* __restrict__ A, int lda, const u16* __restrict__ B, int ldb, int K,
                                           f32x16 (&acc)[2][2], u16* smem) {
  const int tid = opaque_tid(), lane = tid & 63, wave = tid >> 6;
  const int wm = wave >> 1, wn = wave & 1, r = lane & 31, h = lane >> 5;
  const int lrow = tid >> 3, lkc = (tid & 7) * 8;
  GkRegs g0, g1;
  const int nk = K >> 6;
  GK_LOAD(g0, 0)
  GK_LOAD(g1, (nk > 1 ? 1 : 0))
  GK_WRITE(g0, 0)
  __syncthreads();
  for (int kt = 0; kt < nk; kt += 2) {
    GK_LOAD(g0, (kt + 2 < nk ? kt + 2 : nk - 1))
    GK_COMPUTE(0)
    GK_WRITE(g1, 1)
    __syncthreads();
    GK_LOAD(g1, (kt + 3 < nk ? kt + 3 : nk - 1))
    GK_COMPUTE(1)
    GK_WRITE(g0, 0)
    __syncthreads();
  }
}
#endif
__device__ __forceinline__ void acc_zero(f32x16 (&acc)[2][2]) {
#pragma unroll
  for (int i = 0; i < 2; ++i)
#pragma unroll
    for (int j = 0; j < 2; ++j)
#pragma unroll
      for (int e = 0; e < 16; ++e) acc[i][j][e] = 0.f;
}
__device__ __forceinline__ void tile_decode(int t, int NT, int& mt, int& nt) {
  const int g = t / (16 * NT), rem = t % (16 * NT);
  nt = rem / 16; mt = g * 16 + (rem % 16);
}
#define EPI_LOOP(i, j, e) \
  _Pragma("unroll") for (int i = 0; i < 2; ++i) _Pragma("unroll") for (int j = 0; j < 2; ++j) _Pragma("unroll") for (int e = 0; e < 16; ++e)

__device__ __forceinline__ void ph_inproj(const Params& p, int l, unsigned char* smem, int bid, int nb) {
  const u16* H = (const u16*)(p.ws + R_H);
  const u16* Wt = (const u16*)(p.ws + R_W) + WO_IN;
  const int lane = opaque_tid() & 63, wave = opaque_tid() >> 6, wm = wave >> 1, wn = wave & 1, r = lane & 31, h = lane >> 5;
  constexpr int NT = NMIX / 128;
  bool pf = false;
  for (int t = bid; t < 64 * NT; t += nb) {
    int mt, nt; tile_decode(t, NT, mt, nt);
    const int m0 = mt * 256, n0 = nt * 128;
    f32x16 acc[2][2]; acc_zero(acc);
    gemm_kloop(H + (size_t)m0 * 1024, 1024, Wt + (size_t)n0 * 1024, 1024, 1024, acc, (u16*)smem, pf);
    pf = (t + nb < 64 * NT);
    if (pf) { int mt2, nt2; tile_decode(t + nb, NT, mt2, nt2); gemm_prefetch(H + (size_t)mt2 * 256 * 1024, 1024, Wt + (size_t)nt2 * 128 * 1024, 1024, 1024, (u16*)smem); }
    if (n0 < 2048) {
      u16* dst = (u16*)(p.ws + (n0 < 1024 ? R_UA : R_VA));
      const int nb0 = (n0 & 1023) + wn * 64 + r;
      EPI_LOOP(i, j, e) {
        const int m = m0 + wm * 64 + i * 32 + (e & 3) + 8 * (e >> 2) + 4 * h;
        dst[(size_t)m * 1024 + nb0 + j * 32] = f2bf(gelu_tanh(acc[i][j][e]));
      }
    } else if (n0 < 3584) {
      const int seg = (n0 - 2048) >> 9;
      u16* dst = (u16*)(p.ws + (seg == 0 ? R_Q : (seg == 1 ? R_K : R_V)));
      const int nb0 = ((n0 - 2048) & 511) + wn * 64 + r;
      EPI_LOOP(i, j, e) {
        const int m = m0 + wm * 64 + i * 32 + (e & 3) + 8 * (e >> 2) + 4 * h;
        dst[(size_t)m * 512 + nb0 + j * 32] = f2bf(acc[i][j][e]);
      }
    } else if (n0 < 3712) {
      if (wn == 0 && r < 8) {
        float* dst = (float*)(p.ws + R_LOGF);
        const float bfv = p.in[I_B_F_BIAS][l * 8 + r];
#pragma unroll
        for (int i = 0; i < 2; ++i)
#pragma unroll
          for (int e = 0; e < 16; ++e) {
            const int m = m0 + wm * 64 + i * 32 + (e & 3) + 8 * (e >> 2) + 4 * h;
            const float z = acc[i][0][e] + bfv;
            dst[(size_t)m * 8 + r] = -softplusf_(-z);
          }
      }
    } else {
      u16* dst = (u16*)(p.ws + R_PC);
      const int nb0 = (n0 - 3712) + wn * 64 + r;
      EPI_LOOP(i, j, e) {
        const int m = m0 + wm * 64 + i * 32 + (e & 3) + 8 * (e >> 2) + 4 * h;
        dst[(size_t)m * 1792 + nb0 + j * 32] = f2bf(acc[i][j][e]);
      }
    }
  }
}

constexpr int MA_ROW = 136;
__device__ __forceinline__ void mixerA_item(const Params& p, int l, unsigned char* smem, int item) {
  const int c = item >> 2, g = item & 3, tok0 = c * 128, ch0 = g * 256;
  const int tid = opaque_tid(), lane = tid & 63, wave = tid >> 6, r = lane & 31, h = lane >> 5;
  float* stats = (float*)smem;
  u16* Wm = (u16*)(smem + 1024);
  u16* Vt = Wm + 128 * MA_ROW;
  const u16* va = (const u16*)(p.ws + R_VA);
  u16* ua = (u16*)(p.ws + R_UA);
  {
    const int tok = tid >> 2, part = tid & 3;
    const u16* row = va + (size_t)(tok0 + tok) * 1024;
    float s = 0.f, s2 = 0.f;
#pragma unroll 1
    for (int i0 = 0; i0 < 32; i0 += 16) {
      v4u qv[16];
#pragma unroll
      for (int i = 0; i < 16; ++i) qv[i] = *(const v4u*)(row + ((i0 + i) * 4 + part) * 8);
      __builtin_amdgcn_sched_barrier(0);
#pragma unroll
      for (int i = 0; i < 16; ++i) {
#pragma unroll
        for (int e = 0; e < 4; ++e) { const float a = bflo(qv[i][e]), b = bfhi(qv[i][e]); s += a + b; s2 += a * a + b * b; }
      }
    }
    s += __shfl_xor(s, 1); s2 += __shfl_xor(s2, 1);
    s += __shfl_xor(s, 2); s2 += __shfl_xor(s2, 2);
    if (part == 0) {
      const float mu = s * (1.f / 1024.f);
      const float var = fmaxf(s2 * (1.f / 1024.f) - mu * mu, 0.f);
      stats[tok * 2] = mu; stats[tok * 2 + 1] = rsqrtf(var + 1e-5f);
    }
  }
  {
    const int t = tid >> 2, s0 = (tid & 3) * 32;
    const float* wsrc = p.in[I_A_W_S] + ((size_t)(l * 4 + g) * 128 + t) * 128 + s0;
#pragma unroll
    for (int q4 = 0; q4 < 4; ++q4) {
      float f[8];
      *(float4*)&f[0] = *(const float4*)(wsrc + q4 * 8);
      *(float4*)&f[4] = *(const float4*)(wsrc + q4 * 8 + 4);
#pragma unroll
      for (int e = 0; e < 8; ++e) if (s0 + q4 * 8 + e > t) f[e] = 0.f;
      uint4 o; o.x = pk2(f[0], f[1]); o.y = pk2(f[2], f[3]); o.z = pk2(f[4], f[5]); o.w = pk2(f[6], f[7]);
      *(uint4*)(Wm + t * MA_ROW + s0 + q4 * 8) = o;
    }
  }
  __syncthreads();
  {
    const float* lng = p.in[I_A_LN_G] + l * 1024 + ch0;
    const float* lnb = p.in[I_A_LN_B] + l * 1024 + ch0;
#pragma unroll
    for (int i = 0; i < 8; ++i) {
      const int cc = tid + 512 * i, tok = cc >> 5, cg8 = (cc & 31) * 8;
      const uint4 q = *(const uint4*)(va + (size_t)(tok0 + tok) * 1024 + ch0 + cg8);
      const float mu = stats[tok * 2], rs = stats[tok * 2 + 1];
      const u32 w[4] = {q.x, q.y, q.z, q.w};
#pragma unroll
      for (int e = 0; e < 4; ++e) {
        const int d0 = cg8 + 2 * e;
        const float a = (bflo(w[e]) - mu) * rs * lng[d0] + lnb[d0];
        const float b = (bfhi(w[e]) - mu) * rs * lng[d0 + 1] + lnb[d0 + 1];
        Vt[d0 * MA_ROW + tok] = f2bf(a);
        Vt[(d0 + 1) * MA_ROW + tok] = f2bf(b);
      }
    }
  }
  __syncthreads();
  f32x16 acc[4];
#pragma unroll
  for (int ti = 0; ti < 4; ++ti)
#pragma unroll
    for (int e = 0; e < 16; ++e) acc[ti][e] = 0.f;
#pragma unroll
  for (int ks = 0; ks < 8; ++ks) {
    const bf16x8 b = *(const bf16x8*)(Vt + (wave * 32 + r) * MA_ROW + ks * 16 + h * 8);
#pragma unroll
    for (int ti = 0; ti < 4; ++ti) {
      if (16 * ks <= 32 * ti + 31) {
        const bf16x8 a = *(const bf16x8*)(Wm + (ti * 32 + r) * MA_ROW + ks * 16 + h * 8);
        acc[ti] = __builtin_amdgcn_mfma_f32_32x32x16_bf16(a, b, acc[ti], 0, 0, 0);
      }
    }
  }
  {
    const float* bs = p.in[I_A_B_S] + (size_t)(l * 4 + g) * 128;
    const int ch = ch0 + wave * 32 + r;
    float uv[4][16], bsv[4][16];
#pragma unroll
    for (int ti = 0; ti < 4; ++ti)
#pragma unroll
      for (int e = 0; e < 16; ++e) {
        const int t = ti * 32 + (e & 3) + 8 * (e >> 2) + 4 * h;
        uv[ti][e] = bf2f(ua[(size_t)(tok0 + t) * 1024 + ch]);
        bsv[ti][e] = bs[t];
      }
    __builtin_amdgcn_sched_barrier(0);
#pragma unroll
    for (int ti = 0; ti < 4; ++ti)
#pragma unroll
      for (int e = 0; e < 16; ++e) {
        const int t = ti * 32 + (e & 3) + 8 * (e >> 2) + 4 * h;
        ua[(size_t)(tok0 + t) * 1024 + ch] = f2bf(uv[ti][e] * (acc[ti][e] + bsv[ti][e]));
      }
  }
  __syncthreads();
}
__device__ __forceinline__ void cumsum_item(const Params& p, unsigned char* smem, int bh) {
  const int b = bh >> 3, hh = bh & 7, tid = opaque_tid();
  const float* logf_ = (const float*)(p.ws + R_LOGF);
  float* cum = (float*)(p.ws + R_CUM) + (size_t)bh * S;
  float* part = (float*)smem;
  float v[16]; float s = 0.f;
#pragma unroll
  for (int i = 0; i < 16; ++i) { v[i] = logf_[(size_t)(b * S + tid * 16 + i) * 8 + hh]; s += v[i]; }
  part[tid] = s;
  __syncthreads();
  float pre = 0.f;
  for (int i = 0; i < tid; ++i) pre += part[i];
#pragma unroll
  for (int i = 0; i < 16; ++i) { pre += v[i]; cum[tid * 16 + i] = pre; }
  __syncthreads();
}
__device__ __forceinline__ void ph_mixerA(const Params& p, int l, unsigned char* smem, int bid, int nb) {
  for (int it = bid; it < 16; it += nb) cumsum_item(p, smem, it);
}

constexpr int AT_KROW = 72;
constexpr float AT_SKIP = 250.f;
constexpr int AT_STAGE = 64 * AT_KROW * 2 * 2 + 256;
__device__ __forceinline__ void attn_item(const Params& p, unsigned char* smem, int qb, int bh) {
  const int b = bh >> 3, hh = bh & 7;
  const int tid = opaque_tid(), lane = tid & 63, wave = tid >> 6, r = lane & 31, h = lane >> 5;
  const u16* Q = (const u16*)(p.ws + R_Q);
  const u16* Kg = (const u16*)(p.ws + R_K);
  const u16* Vg = (const u16*)(p.ws + R_V);
  u16* Yb = (u16*)(p.ws + R_YB);
  const float* cum = (const float*)(p.ws + R_CUM) + (size_t)bh * S;
  const int q0w = qb * 256 + wave * 32;
  const size_t tokq = (size_t)b * S + q0w + r;
  const float LOG2E = 1.4426950408889634f;
  const float cq0 = cum[qb * 256];
  bf16x8 qf[4];
#pragma unroll
  for (int s = 0; s < 4; ++s) qf[s] = *(const bf16x8*)(Q + tokq * 512 + hh * 64 + s * 16 + h * 8);
  f32x16 accO[2];
#pragma unroll
  for (int d = 0; d < 2; ++d)
#pragma unroll
    for (int e = 0; e < 16; ++e) accO[d][e] = 0.f;
  float mrun = -INFINITY, lrun = 0.f;
  const int nkt = 4 * (qb + 1);
  const int skey = tid >> 3, sdc = (tid & 7) * 8;
  const int vkey = tid & 63, vdc = (tid >> 6) * 8;
  uint4 rk, rv; float rc = 0.f;
  unsigned* cntw = (unsigned*)(smem + 2 * AT_STAGE);
  if (tid == 0) *cntw = 0u;
  __syncthreads();
  if (tid < nkt && (cq0 - cum[tid * 64 + 63]) * LOG2E < -AT_SKIP) atomicAdd(cntw, 1u);
  __syncthreads();
  const int kt0 = (int)*cntw;
  {
    const size_t tk = ((size_t)b * S + (nkt - 1) * 64 + skey) * 512 + hh * 64 + sdc;
    rk = *(const uint4*)(Kg + tk); rv = *(const uint4*)(Vg + ((size_t)b * S + (nkt - 1) * 64 + vkey) * 512 + hh * 64 + vdc);
    if (tid < 64) rc = cum[(nkt - 1) * 64 + tid];
  }
  auto swrite = [&](int buf) {
    u16* Ks = (u16*)(smem + buf * AT_STAGE);
    u16* Vt = Ks + 64 * AT_KROW;
    float* bias = (float*)(smem + buf * AT_STAGE + 64 * AT_KROW * 4);
    *(uint4*)(Ks + skey * AT_KROW + sdc) = rk;
    const u32 w[4] = {rv.x, rv.y, rv.z, rv.w};
#pragma unroll
    for (int e = 0; e < 4; ++e) {
      Vt[(vdc + 2 * e) * AT_KROW + vkey] = (u16)(w[e] & 0xffffu);
      Vt[(vdc + 2 * e + 1) * AT_KROW + vkey] = (u16)(w[e] >> 16);
    }
    if (tid < 64) bias[tid] = (cq0 - rc) * LOG2E;
  };
  swrite((nkt - 1) & 1);
  __syncthreads();
  for (int kt = nkt - 1; kt >= kt0; --kt) {
    const bool more = (kt - 1 >= kt0);
    if (more) {
      const size_t tk = ((size_t)b * S + (kt - 1) * 64 + skey) * 512 + hh * 64 + sdc;
      rk = *(const uint4*)(Kg + tk); rv = *(const uint4*)(Vg + ((size_t)b * S + (kt - 1) * 64 + vkey) * 512 + hh * 64 + vdc);
      if (tid < 64) rc = cum[(kt - 1) * 64 + tid];
    }
    if (kt * 64 <= q0w + 31) {
      const u16* Ks = (const u16*)(smem + (kt & 1) * AT_STAGE);
      const u16* Vt = Ks + 64 * AT_KROW;
      const float* bias = (const float*)(smem + (kt & 1) * AT_STAGE + 64 * AT_KROW * 4);
      f32x16 sc[2];
#pragma unroll
      for (int sub = 0; sub < 2; ++sub) {
#pragma unroll
        for (int e = 0; e < 16; ++e) sc[sub][e] = 0.f;
#pragma unroll
        for (int s = 0; s < 4; ++s) {
          const bf16x8 a = *(const bf16x8*)(Ks + (sub * 32 + r) * AT_KROW + s * 16 + h * 8);
          sc[sub] = __builtin_amdgcn_mfma_f32_32x32x16_bf16(a, qf[s], sc[sub], 0, 0, 0);
        }
      }
      const bool diag = (kt * 64 + 63 > q0w);
      const int qpos = q0w + r;
      float mx = -INFINITY;
#pragma unroll
      for (int sub = 0; sub < 2; ++sub)
#pragma unroll
        for (int e4 = 0; e4 < 4; ++e4) {
          const int kl = sub * 32 + 8 * e4 + 4 * h;
          const float4 bb = *(const float4*)(bias + kl);
          const float bv[4] = {bb.x, bb.y, bb.z, bb.w};
#pragma unroll
          for (int e = 0; e < 4; ++e) sc[sub][e4 * 4 + e] = sc[sub][e4 * 4 + e] * (0.125f * LOG2E) + bv[e];
        }
      if (diag) {
        asm volatile("" ::: "memory");
#pragma unroll
        for (int sub = 0; sub < 2; ++sub)
#pragma unroll
          for (int e = 0; e < 16; ++e)
            if (kt * 64 + sub * 32 + (e & 3) + 8 * (e >> 2) + 4 * h > qpos) sc[sub][e] = -INFINITY;
      }
#pragma unroll
      for (int sub = 0; sub < 2; ++sub)
#pragma unroll
        for (int e = 0; e < 16; ++e) mx = fmaxf(mx, sc[sub][e]);
      mx = fmaxf(mx, __shfl_xor(mx, 32));
      const float mnew = fmaxf(mrun, mx);
      const bool resc = __builtin_amdgcn_ballot_w64(mnew != mrun) != 0ull;
      const float mold = mrun;
      mrun = mnew;
      float ls = 0.f;
      bf16x8 pf[2][2];
#pragma unroll
      for (int sub = 0; sub < 2; ++sub)
#pragma unroll
        for (int s2 = 0; s2 < 2; ++s2) {
          float pv[8];
#pragma unroll
          for (int j = 0; j < 8; ++j) { pv[j] = __builtin_amdgcn_exp2f(sc[sub][8 * s2 + j] - mnew); ls += pv[j]; }
          union { bf16x8 v; u32 w[4]; } cv;
          cv.w[0] = pk2(pv[0], pv[1]); cv.w[1] = pk2(pv[2], pv[3]); cv.w[2] = pk2(pv[4], pv[5]); cv.w[3] = pk2(pv[6], pv[7]);
          pf[sub][s2] = cv.v;
        }
      if (resc) {
        const float alpha = __builtin_amdgcn_exp2f(mold - mnew);
        lrun *= alpha;
#pragma unroll
        for (int d = 0; d < 2; ++d)
#pragma unroll
          for (int e = 0; e < 16; ++e) accO[d][e] *= alpha;
      }
      lrun += ls;
#pragma unroll
      for (int d = 0; d < 2; ++d) {
#pragma unroll
        for (int sub = 0; sub < 2; ++sub)
#pragma unroll
          for (int s2 = 0; s2 < 2; ++s2) {
            const u16* vp = Vt + (d * 32 + r) * AT_KROW + sub * 32 + 16 * s2 + 4 * h;
            union { bf16x8 v; uint2 w[2]; } av;
            av.w[0] = *(const uint2*)(vp);
            av.w[1] = *(const uint2*)(vp + 8);
            accO[d] = __builtin_amdgcn_mfma_f32_32x32x16_bf16(av.v, pf[sub][s2], accO[d], 0, 0, 0);
          }
      }
    }
    if (more) swrite((kt - 1) & 1);
    __syncthreads();
  }
  const float ltot = lrun + __shfl_xor(lrun, 32);
  const float inv = __builtin_amdgcn_rcpf(ltot);
#pragma unroll
  for (int d = 0; d < 2; ++d)
#pragma unroll
    for (int e4 = 0; e4 < 4; ++e4) {
      const int dd = d * 32 + 8 * e4 + 4 * h;
      uint2 o;
      o.x = pk2(accO[d][e4 * 4 + 0] * inv, accO[d][e4 * 4 + 1] * inv);
      o.y = pk2(accO[d][e4 * 4 + 2] * inv, accO[d][e4 * 4 + 3] * inv);
      *(uint2*)(Yb + tokq * 512 + hh * 64 + dd) = o;
    }
}
__device__ __forceinline__ void ph_attn(const Params& p, int l, unsigned char* smem, int bid, int nb) {
  unsigned* qw = (unsigned*)(p.ws + WS_CTR) + 3600 + 64 * l;
  int* nxt = (int*)(smem + 2 * AT_STAGE + 16);
  for (;;) {
    if (opaque_tid() == 0) *nxt = (int)__hip_atomic_fetch_add(qw, 1u, __ATOMIC_RELAXED, __HIP_MEMORY_SCOPE_AGENT);
    __syncthreads();
    const int idx = *nxt;
    __syncthreads();
    if (idx >= 1024) break;
    if (idx < 512) attn_item(p, smem, 31 - (idx >> 4), idx & 15);
    else mixerA_item(p, l, smem, idx - 512);
  }
}

constexpr int PXW = 72, PXG = 136, PXV = 520, PXD = 40;
__device__ __forceinline__ void prep_item(const Params& p, int l, unsigned char* smem, int item) {
  const int tok0 = item * 32, tid = opaque_tid();
  const int lane = tid & 63, wave = tid >> 6, r = lane & 31, h = lane >> 5;
  u16* XW = (u16*)smem;
  u16* XA = XW + 32 * PXW;
  u16* XG = XA + 32 * PXW;
  u16* XV = XG + 32 * PXG;
  u16* XD = XV + 32 * PXV;
  float* VDP = (float*)(XD + 32 * PXD);
  const u16* pc = (const u16*)(p.ws + R_PC);
  const float* mu = p.in[I_C_MU] + l * 1792;
  const u16* Wb = (const u16*)(p.ws + R_W);
  u16* oR = (u16*)(p.ws + RW_R); u16* oW = (u16*)(p.ws + RW_W); u16* oK = (u16*)(p.ws + RW_K);
  u16* oV = (u16*)(p.ws + RW_V); u16* oA = (u16*)(p.ws + RW_A); u16* oG = (u16*)(p.ws + RW_G);
  u16* vf = (u16*)(p.ws + R_VF);
#pragma unroll 1
  for (int i2 = 0; i2 < 14; i2 += 2) {
    uint4 curv[2], prvv[2]; float4 muA[2], muB[2];
#pragma unroll
    for (int u = 0; u < 2; ++u) {
      const int cc = tid + 512 * (i2 + u), tt = cc / 224, c8 = (cc % 224) * 8;
      const int tok = tok0 + tt;
      curv[u] = *(const uint4*)(pc + (size_t)tok * 1792 + c8);
      prvv[u] = make_uint4(0, 0, 0, 0);
      if ((tok & (S - 1)) != 0) prvv[u] = *(const uint4*)(pc + (size_t)(tok - 1) * 1792 + c8);
      muA[u] = *(const float4*)(mu + c8); muB[u] = *(const float4*)(mu + c8 + 4);
    }
    __builtin_amdgcn_sched_barrier(0);
#pragma unroll
    for (int u = 0; u < 2; ++u) {
    const int cc = tid + 512 * (i2 + u), tt = cc / 224, c8 = (cc % 224) * 8;
    const int tok = tok0 + tt;
    const uint4 cur = curv[u], prv = prvv[u];
    const u32 cw[4] = {cur.x, cur.y, cur.z, cur.w}, pw[4] = {prv.x, prv.y, prv.z, prv.w};
    float xs[8];
    const float mv[8] = {muA[u].x, muA[u].y, muA[u].z, muA[u].w, muB[u].x, muB[u].y, muB[u].z, muB[u].w};
#pragma unroll
    for (int e = 0; e < 4; ++e) {
      const float c0 = bflo(cw[e]), c1 = bfhi(cw[e]);
      xs[2 * e] = c0 + (bflo(pw[e]) - c0) * mv[2 * e];
      xs[2 * e + 1] = c1 + (bfhi(pw[e]) - c1) * mv[2 * e + 1];
    }
    if (c8 >= 1536) {
      if (c8 < 1600) {
#pragma unroll
        for (int e = 0; e < 8; ++e) xs[e] = 1.f - 2.f * __builtin_amdgcn_rcpf(1.f + __expf(2.f * xs[e]));
      } else if (c8 >= 1664) {
#pragma unroll
        for (int e = 0; e < 8; ++e) xs[e] = sigmoidf_(xs[e]);
      }
    }
    uint4 o; o.x = pk2(xs[0], xs[1]); o.y = pk2(xs[2], xs[3]); o.z = pk2(xs[4], xs[5]); o.w = pk2(xs[6], xs[7]);
    if (c8 < 512) *(uint4*)(oR + (size_t)tok * 512 + c8) = o;
    else if (c8 < 1024) *(uint4*)(oK + (size_t)tok * 512 + (c8 - 512)) = o;
    else if (c8 < 1536) {
      if (l == 0) { *(uint4*)(oV + (size_t)tok * 512 + (c8 - 1024)) = o; *(uint4*)(vf + (size_t)tok * 512 + (c8 - 1024)) = o; }
      else *(uint4*)(XV + tt * PXV + (c8 - 1024)) = o;
    } else if (c8 < 1600) *(uint4*)(XW + tt * PXW + (c8 - 1536)) = o;
    else if (c8 < 1664) *(uint4*)(XA + tt * PXW + (c8 - 1600)) = o;
    else *(uint4*)(XG + tt * PXG + (c8 - 1664)) = o;
  }
  }
  __syncthreads();
  const int c0 = wave * 64;
  f32x16 acc[2];
#define LR_GEMM(XP, PITCH, WOFF, KD)                                                                            \
  {                                                                                                             \
    bf16x8 bqs[(KD) / 16][2];                                                                                   \
    _Pragma("unroll") for (int ks = 0; ks < (KD) / 16; ++ks) _Pragma("unroll") for (int nt = 0; nt < 2; ++nt)   \
      bqs[ks][nt] = *(const bf16x8*)(Wb + (WOFF) + (size_t)(c0 + 32 * nt + r) * (KD) + ks * 16 + h * 8);        \
    __builtin_amdgcn_sched_barrier(0);                                                                          \
    _Pragma("unroll") for (int nt = 0; nt < 2; ++nt) _Pragma("unroll") for (int e = 0; e < 16; ++e) acc[nt][e] = 0.f; \
    _Pragma("unroll") for (int ks = 0; ks < (KD) / 16; ++ks) {                                                   \
      const bf16x8 a = *(const bf16x8*)((XP) + r * (PITCH) + ks * 16 + h * 8);                                    \
      _Pragma("unroll") for (int nt = 0; nt < 2; ++nt)                                                            \
        acc[nt] = __builtin_amdgcn_mfma_f32_32x32x16_bf16(a, bqs[ks][nt], acc[nt], 0, 0, 0);                      \
    }                                                                                                           \
  }
  LR_GEMM(XW, PXW, WO_WUP, 64)
#pragma unroll
  for (int nt = 0; nt < 2; ++nt) {
    const int c = c0 + 32 * nt + r;
    const float w0 = p.in[I_C_W0][l * 512 + c];
#pragma unroll
    for (int e = 0; e < 16; ++e) {
      const int t = (e & 3) + 8 * (e >> 2) + 4 * h;
      oW[(size_t)(tok0 + t) * 512 + c] = f2bf(-softplusf_(-(w0 + acc[nt][e])) - 0.5f);
    }
  }
  LR_GEMM(XA, PXW, WO_AUP, 64)
#pragma unroll
  for (int nt = 0; nt < 2; ++nt) {
    const int c = c0 + 32 * nt + r;
    const float a00 = p.in[I_C_A0][l * 512 + c];
#pragma unroll
    for (int e = 0; e < 16; ++e) {
      const int t = (e & 3) + 8 * (e >> 2) + 4 * h;
      oA[(size_t)(tok0 + t) * 512 + c] = f2bf(sigmoidf_(a00 + acc[nt][e]));
    }
  }
  LR_GEMM(XG, PXG, WO_GUP, 128)
#pragma unroll
  for (int nt = 0; nt < 2; ++nt) {
    const int c = c0 + 32 * nt + r;
#pragma unroll
    for (int e = 0; e < 16; ++e) {
      const int t = (e & 3) + 8 * (e >> 2) + 4 * h;
      oG[(size_t)(tok0 + t) * 512 + c] = f2bf(acc[nt][e]);
    }
  }
  if (l > 0) {
    {
      f32x16 pacc;
#pragma unroll
      for (int e = 0; e < 16; ++e) pacc[e] = 0.f;
#pragma unroll
      for (int ks = 0; ks < 4; ++ks) {
        const bf16x8 a = *(const bf16x8*)(XV + r * PXV + wave * 64 + ks * 16 + h * 8);
        const bf16x8 bq = *(const bf16x8*)(Wb + WO_VDN + (size_t)r * 512 + wave * 64 + ks * 16 + h * 8);
        pacc = __builtin_amdgcn_mfma_f32_32x32x16_bf16(a, bq, pacc, 0, 0, 0);
      }
#pragma unroll
      for (int e = 0; e < 16; ++e) VDP[(wave * 32 + (e & 3) + 8 * (e >> 2) + 4 * h) * 33 + r] = pacc[e];
    }
    __syncthreads();
#pragma unroll
    for (int q = 0; q < 2; ++q) {
      const int o = tid + 512 * q, t = o >> 5, m = o & 31;
      float sm = 0.f;
#pragma unroll
      for (int w8 = 0; w8 < 8; ++w8) sm += VDP[(w8 * 32 + t) * 33 + m];
      XD[t * PXD + m] = f2bf(sm);
    }
    __syncthreads();
#pragma unroll
    for (int nt = 0; nt < 2; ++nt)
#pragma unroll
      for (int e = 0; e < 16; ++e) acc[nt][e] = 0.f;
#pragma unroll
    for (int ks = 0; ks < 2; ++ks) {
      const bf16x8 a = *(const bf16x8*)(XD + r * PXD + ks * 16 + h * 8);
#pragma unroll
      for (int nt = 0; nt < 2; ++nt) {
        const bf16x8 bq = *(const bf16x8*)(Wb + WO_VUP + (size_t)(c0 + 32 * nt + r) * 64 + ks * 16 + h * 8);
        acc[nt] = __builtin_amdgcn_mfma_f32_32x32x16_bf16(a, bq, acc[nt], 0, 0, 0);
      }
    }
    float vfv[2][16];
#pragma unroll
    for (int nt = 0; nt < 2; ++nt)
#pragma unroll
      for (int e = 0; e < 16; ++e) vfv[nt][e] = bf2f(vf[(size_t)(tok0 + (e & 3) + 8 * (e >> 2) + 4 * h) * 512 + c0 + 32 * nt + r]);
    __builtin_amdgcn_sched_barrier(0);
#pragma unroll
    for (int nt = 0; nt < 2; ++nt) {
      const int c = c0 + 32 * nt + r;
      const float v0 = p.in[I_C_V0][(l - 1) * 512 + c];
#pragma unroll
      for (int e = 0; e < 16; ++e) {
        const int t = (e & 3) + 8 * (e >> 2) + 4 * h;
        const float gate = sigmoidf_(v0 + acc[nt][e]);
        const float v = bf2f(XV[t * PXV + c]);
        oV[(size_t)(tok0 + t) * 512 + c] = f2bf(v + (vfv[nt][e] - v) * gate);
      }
    }
  }
#undef LR_GEMM
  __syncthreads();
}
__device__ __forceinline__ void ph_prep(const Params& p, int l, unsigned char* smem, int bid, int nb) {
  for (int it = bid; it < T / 32; it += nb) prep_item(p, l, smem, it);
}

struct FragPtrs { unsigned char* fa; unsigned char* fb; unsigned char* fc; unsigned char* fd; };
__device__ __forceinline__ FragPtrs frag_ptrs(const Params& p, int l) {
  FragPtrs f;
  f.fa = p.ws + 9 * U;
  f.fb = (l == 0) ? (unsigned char*)p.out : p.ws + R_VF;
  f.fc = p.ws + R_W + WO_GU * 2;
  f.fd = p.ws + R_W + WO_IN * 2;
  return f;
}
constexpr int P2P = 72;
__device__ __forceinline__ void prep2_item(const Params& p, int l, const FragPtrs& fp, u16* sw, int rec, int lane) {
  const int bh = rec >> 8, c = rec & 255, b = bh >> 3, hh = bh & 7, cb = hh * 64;
  const int r = lane & 31, h = lane >> 5;
  const size_t tok0 = (size_t)b * S + c * 32;
  const u16* gR = (const u16*)(p.ws + RW_R); const u16* gW = (const u16*)(p.ws + RW_W);
  const u16* gK = (const u16*)(p.ws + RW_K); const u16* gA = (const u16*)(p.ws + RW_A);
  u16* sA = sw; u16* sR = sA + 32 * P2P; u16* sB = sR + 32 * P2P; u16* sK = sB + 32 * P2P;
  const float kkc = p.in[I_C_K_K][l * 512 + cb + lane], kac = p.in[I_C_K_A][l * 512 + cb + lane];
  float G = 0.f;
  {
    const u16* pR = gR + tok0 * 512 + cb + lane; const u16* pW = gW + tok0 * 512 + cb + lane;
    const u16* pK = gK + tok0 * 512 + cb + lane; const u16* pA = gA + tok0 * 512 + cb + lane;
#pragma unroll 1
    for (int t8 = 0; t8 < 32; t8 += 8) {
    u16 raw[8][4];
#pragma unroll
    for (int u = 0; u < 8; ++u) { raw[u][0] = pR[(t8 + u) * 512]; raw[u][1] = pW[(t8 + u) * 512]; raw[u][2] = pK[(t8 + u) * 512]; raw[u][3] = pA[(t8 + u) * 512]; }
    __builtin_amdgcn_sched_barrier(0);
#pragma unroll
    for (int u = 0; u < 8; ++u) {
      const int t = t8 + u;
      const float rv = bf2f(raw[u][0]), wv = bf2f(raw[u][1]), kv = bf2f(raw[u][2]), av = bf2f(raw[u][3]);
      const float ld = -__expf(wv);
      const float Gp = G;
      G += ld;
      const float kr = kv * kkc;
      const float n2 = wave_sum_fast(kr * kr);
      const float kk = kr * __builtin_amdgcn_rsqf(fmaxf(n2, 1e-24f));
      const float beta = kk * av, kp = kv * (1.f + (av - 1.f) * kac);
      const float eG = __expf(G), eGp = __expf(Gp), eGn = __expf(-G);
      sA[t * P2P + lane] = f2bf(-kk * eGp);
      sR[t * P2P + lane] = f2bf(rv * eG);
      sB[t * P2P + lane] = f2bf(beta * eGn);
      sK[t * P2P + lane] = f2bf(kp * eGn);
    }
    }
  }
  const float GL = __expf(G);
  *(float*)(fp.fd + (size_t)rec * 2304 + 2048 + lane * 4) = GL;
  const float GLx = __shfl_xor(GL, 32);
  __builtin_amdgcn_wave_barrier();
  __builtin_amdgcn_s_waitcnt(0xc07f);
  asm volatile("" ::: "memory");
#pragma unroll
  for (int jt = 0; jt < 2; ++jt) {
    const float gl = (jt == h) ? GL : GLx;
#pragma unroll
    for (int ks = 0; ks < 2; ++ks) {
      float vb[8], vk[8];
#pragma unroll
      for (int e = 0; e < 8; ++e) {
        const int t = 16 * ks + 8 * (e >> 2) + 4 * h + (e & 3);
        vb[e] = bf2f(sB[t * P2P + 32 * jt + r]) * gl;
        vk[e] = bf2f(sK[t * P2P + 32 * jt + r]) * gl;
      }
      *(uint4*)(fp.fa + (size_t)rec * 14336 + (8 + jt * 2 + ks) * 1024 + lane * 16) = make_uint4(pk2(vb[0], vb[1]), pk2(vb[2], vb[3]), pk2(vb[4], vb[5]), pk2(vb[6], vb[7]));
      *(uint4*)(fp.fb + (size_t)rec * 4096 + (jt * 2 + ks) * 1024 + lane * 16) = make_uint4(pk2(vk[0], vk[1]), pk2(vk[2], vk[3]), pk2(vk[4], vk[5]), pk2(vk[6], vk[7]));
    }
  }
#pragma unroll
  for (int ks = 0; ks < 4; ++ks) {
    const uint2 a0 = *(const uint2*)(sA + r * P2P + 16 * ks + 4 * h), a1 = *(const uint2*)(sA + r * P2P + 16 * ks + 8 + 4 * h);
    const uint2 r0 = *(const uint2*)(sR + r * P2P + 16 * ks + 4 * h), r1 = *(const uint2*)(sR + r * P2P + 16 * ks + 8 + 4 * h);
    *(uint4*)(fp.fa + (size_t)rec * 14336 + ks * 1024 + lane * 16) = make_uint4(a0.x, a0.y, a1.x, a1.y);
    *(uint4*)(fp.fa + (size_t)rec * 14336 + (4 + ks) * 1024 + lane * 16) = make_uint4(r0.x, r0.y, r1.x, r1.y);
  }
  f32x16 Dab, Dak, Drb, Drk;
#pragma unroll
  for (int e = 0; e < 16; ++e) { Dab[e] = 0.f; Dak[e] = 0.f; Drb[e] = 0.f; Drk[e] = 0.f; }
#pragma unroll
  for (int ks = 0; ks < 4; ++ks) {
    const bf16x8 fb = *(const bf16x8*)(sB + r * P2P + ks * 16 + h * 8);
    const bf16x8 fk = *(const bf16x8*)(sK + r * P2P + ks * 16 + h * 8);
    const bf16x8 fa = *(const bf16x8*)(sA + r * P2P + ks * 16 + h * 8);
    const bf16x8 fr = *(const bf16x8*)(sR + r * P2P + ks * 16 + h * 8);
    Dab = __builtin_amdgcn_mfma_f32_32x32x16_bf16(fb, fa, Dab, 0, 0, 0);
    Dak = __builtin_amdgcn_mfma_f32_32x32x16_bf16(fk, fa, Dak, 0, 0, 0);
    Drb = __builtin_amdgcn_mfma_f32_32x32x16_bf16(fb, fr, Drb, 0, 0, 0);
    Drk = __builtin_amdgcn_mfma_f32_32x32x16_bf16(fk, fr, Drk, 0, 0, 0);
  }
#pragma unroll
  for (int e = 0; e < 16; ++e) {
    const int sI = (e & 3) + 8 * (e >> 2) + 4 * h;
    if (!(sI < r)) { Dab[e] = 0.f; Dak[e] = 0.f; }
    if (!(sI <= r)) { Drb[e] = 0.f; Drk[e] = 0.f; }
  }
#pragma unroll
  for (int ks = 0; ks < 2; ++ks) {
    uint4 w;
    w.x = pk2(Dak[8 * ks + 0], Dak[8 * ks + 1]); w.y = pk2(Dak[8 * ks + 2], Dak[8 * ks + 3]); w.z = pk2(Dak[8 * ks + 4], Dak[8 * ks + 5]); w.w = pk2(Dak[8 * ks + 6], Dak[8 * ks + 7]);
    *(uint4*)(fp.fc + (size_t)rec * 4096 + ks * 1024 + lane * 16) = w;
    w.x = pk2(Drb[8 * ks + 0], Drb[8 * ks + 1]); w.y = pk2(Drb[8 * ks + 2], Drb[8 * ks + 3]); w.z = pk2(Drb[8 * ks + 4], Drb[8 * ks + 5]); w.w = pk2(Drb[8 * ks + 6], Drb[8 * ks + 7]);
    *(uint4*)(fp.fc + (size_t)rec * 4096 + (2 + ks) * 1024 + lane * 16) = w;
    w.x = pk2(Drk[8 * ks + 0], Drk[8 * ks + 1]); w.y = pk2(Drk[8 * ks + 2], Drk[8 * ks + 3]); w.z = pk2(Drk[8 * ks + 4], Drk[8 * ks + 5]); w.w = pk2(Drk[8 * ks + 6], Drk[8 * ks + 7]);
    *(uint4*)(fp.fd + (size_t)rec * 2304 + ks * 1024 + lane * 16) = w;
  }
  __builtin_amdgcn_wave_barrier();
  __builtin_amdgcn_s_waitcnt(0xc07f);
  asm volatile("" ::: "memory");
  float* LT = (float*)sB;
#pragma unroll
  for (int q = 0; q < 4; ++q) *(float4*)(LT + r * 36 + 8 * q + 4 * h) = make_float4(Dab[4 * q], Dab[4 * q + 1], Dab[4 * q + 2], Dab[4 * q + 3]);
  __builtin_amdgcn_wave_barrier();
  __builtin_amdgcn_s_waitcnt(0xc07f);
  asm volatile("" ::: "memory");
  float x[32];
#pragma unroll
  for (int m = 0; m < 32; ++m) x[m] = 0.f;
#pragma unroll
  for (int sI = 31; sI >= 1; --sI) {
    const float xs = x[sI] + ((sI == r) ? 1.f : 0.f);
    x[sI] = xs;
#pragma unroll
    for (int m4 = 0; m4 < sI; m4 += 4) {
      const float4 v = *(const float4*)(LT + sI * 36 + m4);
      x[m4] += v.x * xs; x[m4 + 1] += v.y * xs; x[m4 + 2] += v.z * xs; x[m4 + 3] += v.w * xs;
    }
  }
  x[0] += (r == 0) ? 1.f : 0.f;
#pragma unroll
  for (int ks = 0; ks < 2; ++ks) {
    uint4 w;
    w.x = h ? pk2(x[16 * ks + 4], x[16 * ks + 5]) : pk2(x[16 * ks + 0], x[16 * ks + 1]);
    w.y = h ? pk2(x[16 * ks + 6], x[16 * ks + 7]) : pk2(x[16 * ks + 2], x[16 * ks + 3]);
    w.z = h ? pk2(x[16 * ks + 12], x[16 * ks + 13]) : pk2(x[16 * ks + 8], x[16 * ks + 9]);
    w.w = h ? pk2(x[16 * ks + 14], x[16 * ks + 15]) : pk2(x[16 * ks + 10], x[16 * ks + 11]);
    *(uint4*)(fp.fa + (size_t)rec * 14336 + (12 + ks) * 1024 + lane * 16) = w;
  }
  __builtin_amdgcn_wave_barrier();
  __builtin_amdgcn_s_waitcnt(0xc07f);
  asm volatile("" ::: "memory");
}
__device__ __forceinline__ void ph_prep2(const Params& p, int l, unsigned char* smem, int bid, int nb) {
  const int lane = opaque_tid() & 63, wave = opaque_tid() >> 6;
  const FragPtrs fp = frag_ptrs(p, l);
  u16* sw = (u16*)(smem + wave * (4 * 32 * P2P * 2));
  for (int rec = bid * 8 + wave; rec < 4096; rec += nb * 8) prep2_item(p, l, fp, sw, rec, lane);
}

__device__ __forceinline__ bf16x8 pack8(const f32x16& a, int s2) {
  union { bf16x8 v; u32 w[4]; } cv;
  cv.w[0] = pk2(a[8 * s2 + 0], a[8 * s2 + 1]); cv.w[1] = pk2(a[8 * s2 + 2], a[8 * s2 + 3]);
  cv.w[2] = pk2(a[8 * s2 + 4], a[8 * s2 + 5]); cv.w[3] = pk2(a[8 * s2 + 6], a[8 * s2 + 7]);
  return cv.v;
}
constexpr int SC_SLOT = 24 * 1024 + 256 + 4096, SC_NS = 5;
__device__ __forceinline__ void ph_scan2(const Params& p, int l, unsigned char* smem, int bid, int nb) {
  const int lane = opaque_tid() & 63, wave = __builtin_amdgcn_readfirstlane(opaque_tid() >> 6), r = lane & 31, h = lane >> 5;
  const FragPtrs fp = frag_ptrs(p, l);
  const u16* gV = (const u16*)(p.ws + RW_V);
  u16* gY = (u16*)(p.ws + R_YC);
  for (int bh = bid; bh < 16; bh += nb) {
    const size_t rec0 = (size_t)bh * 256;
    if (wave >= 2) {
      const int lw = wave - 2;
      const size_t tbL = (size_t)(bh >> 3) * S; const int cbL = (bh & 7) * 64;
#define SC_ISSUE(C)                                                                                                              \
      {                                                                                                                          \
        const int cc_ = (C) < 256 ? (C) : 255;                                                                                   \
        unsigned char* slot_ = smem + ((C) % SC_NS) * SC_SLOT;                                                                   \
        const size_t rec_ = rec0 + cc_;                                                                                          \
        _Pragma("unroll") for (int q = 0; q < 4; ++q) {                                                                          \
          const int f = lw * 4 + q;                                                                                              \
          const unsigned char* src_ = f < 14 ? fp.fa + rec_ * 14336 + f * 1024                                                   \
                                    : (f < 18 ? fp.fb + rec_ * 4096 + (f - 14) * 1024                                            \
                                    : (f < 22 ? fp.fc + rec_ * 4096 + (f - 18) * 1024 : fp.fd + rec_ * 2304 + (f - 22) * 1024)); \
          __builtin_amdgcn_global_load_lds((const unsigned*)(src_ + lane * 16), (unsigned*)(slot_ + f * 1024), 16, 0, 0);         \
        }                                                                                                                        \
        if (lw == 5) __builtin_amdgcn_global_load_lds((const unsigned*)(fp.fd + rec_ * 2304 + 2048 + lane * 4), (unsigned*)(slot_ + 24576), 4, 0, 0); \
        if (lw < 4) __builtin_amdgcn_global_load_lds((const unsigned*)(gV + (tbL + cc_ * 32 + lw * 8 + (lane >> 3)) * 512 + cbL + (lane & 7) * 8), (unsigned*)(slot_ + 24832 + lw * 1024), 16, 0, 0); \
      }
      SC_ISSUE(0) SC_ISSUE(1) SC_ISSUE(2) SC_ISSUE(3)
      if (lw == 4) asm volatile("s_waitcnt vmcnt(12)" ::: "memory"); else asm volatile("s_waitcnt vmcnt(15)" ::: "memory");
      __builtin_amdgcn_s_barrier();
#pragma unroll 1
      for (int c = 0; c < 256; ++c) {
        SC_ISSUE(c + 4)
        if (lw == 4) asm volatile("s_waitcnt vmcnt(12)" ::: "memory"); else asm volatile("s_waitcnt vmcnt(15)" ::: "memory");
        __builtin_amdgcn_s_barrier();
      }
      asm volatile("s_waitcnt vmcnt(0)" ::: "memory");
#undef SC_ISSUE
    } else {
      const int it = wave;
      const int b = bh >> 3, hh = bh & 7, cb = hh * 64;
      const size_t tb = (size_t)b * S;
      const int voff = (4 * h) * 512 + r;
      f32x16 ST[2];
#pragma unroll
      for (int jt = 0; jt < 2; ++jt)
#pragma unroll
        for (int e = 0; e < 16; ++e) ST[jt][e] = 0.f;
      asm volatile("s_waitcnt lgkmcnt(0)" ::: "memory");
      __builtin_amdgcn_s_barrier();
#pragma unroll 1
      for (int c = 0; c < 256; ++c) {
        const unsigned char* slot = smem + (c % SC_NS) * SC_SLOT;
#define FR_(f) (*(const bf16x8*)(slot + (f) * 1024 + lane * 16))
        bf16x8 fA[10];
#pragma unroll
        for (int ks = 0; ks < 4; ++ks) { fA[ks] = FR_(ks); fA[6 + ks] = FR_(4 + ks); }
#pragma unroll
        for (int ks = 0; ks < 2; ++ks) fA[4 + ks] = FR_(18 + ks);
        float4 gm[2][4];
#pragma unroll
        for (int jt = 0; jt < 2; ++jt)
#pragma unroll
          for (int q = 0; q < 4; ++q) gm[jt][q] = *(const float4*)(slot + 24576 + (32 * jt + 8 * q + 4 * h) * 4);
        __builtin_amdgcn_sched_barrier(0);
        bf16x8 fB[14];
#pragma unroll
        for (int ks = 0; ks < 2; ++ks) fB[ks] = FR_(12 + ks);
#pragma unroll
        for (int q = 0; q < 4; ++q) { fB[2 + q] = FR_(8 + q); fB[6 + q] = FR_(14 + q); }
        bf16x8 Vf[2];
        {
          const u16* vt = (const u16*)(slot + 24832) + 32 * it + r;
#pragma unroll
          for (int ks = 0; ks < 2; ++ks) {
            union { bf16x8 v; u16 e[8]; } cv;
#pragma unroll
            for (int e = 0; e < 8; ++e) cv.e[e] = vt[(16 * ks + 8 * (e >> 2) + 4 * h + (e & 3)) * 64];
            Vf[ks] = cv.v;
          }
        }
        __builtin_amdgcn_sched_barrier(0);
        bf16x8 stb[4];
#pragma unroll
        for (int ks = 0; ks < 4; ++ks) stb[ks] = pack8(ST[ks >> 1], ks & 1);
        f32x16 N[2];
#pragma unroll
        for (int jt = 0; jt < 2; ++jt)
#pragma unroll
          for (int q = 0; q < 4; ++q) {
            N[jt][4 * q + 0] = ST[jt][4 * q + 0] * gm[jt][q].x; N[jt][4 * q + 1] = ST[jt][4 * q + 1] * gm[jt][q].y;
            N[jt][4 * q + 2] = ST[jt][4 * q + 2] * gm[jt][q].z; N[jt][4 * q + 3] = ST[jt][4 * q + 3] * gm[jt][q].w;
          }
        f32x16 X1;
#pragma unroll
        for (int e = 0; e < 16; ++e) X1[e] = 0.f;
#pragma unroll
        for (int ks = 0; ks < 4; ++ks) X1 = __builtin_amdgcn_mfma_f32_32x32x16_bf16(fA[ks], stb[ks], X1, 0, 0, 0);
#pragma unroll
        for (int ks = 0; ks < 2; ++ks) X1 = __builtin_amdgcn_mfma_f32_32x32x16_bf16(fA[4 + ks], Vf[ks], X1, 0, 0, 0);
        f32x16 Y;
#pragma unroll
        for (int e = 0; e < 16; ++e) Y[e] = 0.f;
#pragma unroll
        for (int ks = 0; ks < 4; ++ks) Y = __builtin_amdgcn_mfma_f32_32x32x16_bf16(fA[6 + ks], stb[ks], Y, 0, 0, 0);
        f32x16 Ut;
#pragma unroll
        for (int e = 0; e < 16; ++e) Ut[e] = 0.f;
#pragma unroll
        for (int ks = 0; ks < 2; ++ks) Ut = __builtin_amdgcn_mfma_f32_32x32x16_bf16(fB[ks], pack8(X1, ks), Ut, 0, 0, 0);
        __builtin_amdgcn_sched_barrier(0);
#pragma unroll
        for (int ks = 0; ks < 2; ++ks) { fB[10 + ks] = FR_(20 + ks); fB[12 + ks] = FR_(22 + ks); }
        __builtin_amdgcn_sched_barrier(0);
        bf16x8 utb[2];
#pragma unroll
        for (int ks = 0; ks < 2; ++ks) utb[ks] = pack8(Ut, ks);
#pragma unroll
        for (int jt = 0; jt < 2; ++jt) {
#pragma unroll
          for (int ks = 0; ks < 2; ++ks) N[jt] = __builtin_amdgcn_mfma_f32_32x32x16_bf16(fB[2 + jt * 2 + ks], utb[ks], N[jt], 0, 0, 0);
#pragma unroll
          for (int ks = 0; ks < 2; ++ks) N[jt] = __builtin_amdgcn_mfma_f32_32x32x16_bf16(fB[6 + jt * 2 + ks], Vf[ks], N[jt], 0, 0, 0);
        }
#pragma unroll
        for (int ks = 0; ks < 2; ++ks) Y = __builtin_amdgcn_mfma_f32_32x32x16_bf16(fB[10 + ks], utb[ks], Y, 0, 0, 0);
#pragma unroll
        for (int ks = 0; ks < 2; ++ks) Y = __builtin_amdgcn_mfma_f32_32x32x16_bf16(fB[12 + ks], Vf[ks], Y, 0, 0, 0);
        ST[0] = N[0]; ST[1] = N[1];
#pragma unroll
        for (int e = 0; e < 16; ++e) {
          u16* yb_ = gY + (tb + c * 32 + 8 * (e >> 2)) * 512 + cb + 32 * it;
          yb_[voff + (e & 3) * 512] = f2bf(Y[e]);
        }
        asm volatile("s_waitcnt lgkmcnt(0)" ::: "memory");
        __builtin_amdgcn_s_barrier();
#undef FR_
      }
    }
  }
}

__device__ __forceinline__ void ph_post(const Params& p, int l, const float* xin, int bid, int nb) {
  const int lane = opaque_tid() & 63, wave = opaque_tid() >> 6;
  ph_rmsnorm(xin, p.in[I_NORM_MIX] + l * 1024, (u16*)(p.ws + R_H2), nullptr, bid * 8 + wave, nb * 8);
  const u16* gR = (const u16*)(p.ws + RW_R); const u16* gK = (const u16*)(p.ws + RW_K);
  const u16* gV = (const u16*)(p.ws + RW_V); const u16* gA = (const u16*)(p.ws + RW_A); const u16* gG = (const u16*)(p.ws + RW_G);
  u16* gY = (u16*)(p.ws + R_YC);
  const int gw = bid * 8 + wave, hh = gw & 7, c = hh * 64 + lane;
  const float cka = p.in[I_C_K_A][l * 512 + c], crk = p.in[I_C_R_K][l * 512 + c];
  const float clg = p.in[I_C_LNX_G][l * 512 + c], clb = p.in[I_C_LNX_B][l * 512 + c];
  const int ngw = nb * 8;
  for (int it0 = gw; it0 < T * 8; it0 += 4 * ngw) {
    float y[4], rv[4], kv[4], vv[4], av[4], gv[4];
    u16 raw[4][6];
#pragma unroll
    for (int u = 0; u < 4; ++u) {
      const int it = it0 + u * ngw;
      const size_t idx = (size_t)((it < T * 8 ? it : gw) >> 3) * 512 + c;
      raw[u][0] = gY[idx]; raw[u][1] = gR[idx]; raw[u][2] = gK[idx]; raw[u][3] = gV[idx]; raw[u][4] = gA[idx]; raw[u][5] = gG[idx];
    }
    __builtin_amdgcn_sched_barrier(0);
#pragma unroll
    for (int u = 0; u < 4; ++u) {
      y[u] = bf2f(raw[u][0]); rv[u] = bf2f(raw[u][1]); kv[u] = bf2f(raw[u][2]); vv[u] = bf2f(raw[u][3]); av[u] = bf2f(raw[u][4]); gv[u] = bf2f(raw[u][5]);
    }
#pragma unroll
    for (int u = 0; u < 4; ++u) {
      const int it = it0 + u * ngw;
      const float mu = wave_sum_fast(y[u]) * (1.f / 64.f);
      const float dv = y[u] - mu;
      const float var = wave_sum_fast(dv * dv) * (1.f / 64.f);
      const float kp = kv[u] * (1.f + (av[u] - 1.f) * cka);
      const float bonus = wave_sum_fast(rv[u] * kp * crk);
      float o = dv * rsqrtf(var + 64e-5f) * clg + clb;
      o = (o + bonus * vv[u]) * gv[u];
      if (it < T * 8) gY[(size_t)(it >> 3) * 512 + c] = f2bf(o);
    }
  }
}

__device__ __forceinline__ void ph_merge(const Params& p, int l, unsigned char* smem, int bid, int nb) {
  const u16* H2 = (const u16*)(p.ws + R_H2);
  const u16* Wb = (const u16*)(p.ws + R_W);
  u16* Mg = (u16*)(p.ws + R_MERGED);
  const int lane = opaque_tid() & 63, wave = opaque_tid() >> 6, wm = wave >> 1, wn = wave & 1, r = lane & 31, h = lane >> 5;
  bool pf = false;
  for (int t = bid; t < 64 * 8; t += nb) {
    int mt, nt; tile_decode(t, 8, mt, nt);
    const int m0 = mt * 256, n0 = nt * 128;
    f32x16 out[2][2]; acc_zero(out);
#pragma unroll 1
    for (int br = 0; br < 3; ++br) {
      f32x16 acc[2][2]; acc_zero(acc);
      gemm_kloop(H2 + (size_t)m0 * 1024, 1024, Wb + WO_IN + (size_t)(NMIX + br * 1024 + n0) * 1024, 1024, 1024, acc, (u16*)smem, pf, false);
      const u16* Y; const u16* P; int K;
      if (br == 0) { Y = (const u16*)(p.ws + R_UA) + (size_t)m0 * 1024; P = Wb + WO_PA + (size_t)n0 * 1024; K = 1024; }
      else if (br == 1) { Y = (const u16*)(p.ws + R_YB) + (size_t)m0 * 512; P = Wb + WO_PB + (size_t)n0 * 512; K = 512; }
      else { Y = (const u16*)(p.ws + R_YC) + (size_t)m0 * 512; P = Wb + WO_PC + (size_t)n0 * 512; K = 512; }
      gemm_prefetch(Y, K, P, K, K, (u16*)smem);
      const float* gb = p.in[I_GATE_BIAS] + (size_t)(l * 3 + br) * 1024 + n0 + wn * 64 + r;
      u32 gpk[2][2][8];
#pragma unroll
      for (int i = 0; i < 2; ++i)
#pragma unroll
        for (int j = 0; j < 2; ++j) {
          const float bj = gb[j * 32];
#pragma unroll
          for (int e = 0; e < 8; ++e) gpk[i][j][e] = pk2(sigmoidf_(acc[i][j][2 * e] + bj), sigmoidf_(acc[i][j][2 * e + 1] + bj));
        }
      acc_zero(acc);
      gemm_kloop(Y, K, P, K, K, acc, (u16*)smem, true, false);
      pf = true;
      if (br < 2) {
        gemm_prefetch(H2 + (size_t)m0 * 1024, 1024, Wb + WO_IN + (size_t)(NMIX + (br + 1) * 1024 + n0) * 1024, 1024, 1024, (u16*)smem);
      } else if (t + nb < 64 * 8) {
        int mt2, nt2; tile_decode(t + nb, 8, mt2, nt2);
        gemm_prefetch(H2 + (size_t)mt2 * 256 * 1024, 1024, Wb + WO_IN + (size_t)(NMIX + nt2 * 128) * 1024, 1024, 1024, (u16*)smem);
      } else pf = false;
#pragma unroll
      for (int i = 0; i < 2; ++i)
#pragma unroll
        for (int j = 0; j < 2; ++j)
#pragma unroll
          for (int e = 0; e < 8; ++e) {
            out[i][j][2 * e] += bflo(gpk[i][j][e]) * acc[i][j][2 * e];
            out[i][j][2 * e + 1] += bfhi(gpk[i][j][e]) * acc[i][j][2 * e + 1];
          }
    }
    EPI_LOOP(i, j, e) {
      const int m = m0 + wm * 64 + i * 32 + (e & 3) + 8 * (e >> 2) + 4 * h;
      Mg[(size_t)m * 1024 + n0 + wn * 64 + j * 32 + r] = f2bf(out[i][j][e]);
    }
  }
}

__device__ __forceinline__ void ph_resgemm(const u16* A, int K, const u16* Wt, const float* xin, float* xr, unsigned char* smem, int bid, int nb) {
  const int lane = opaque_tid() & 63, wave = opaque_tid() >> 6, wm = wave >> 1, wn = wave & 1, r = lane & 31, h = lane >> 5;
  bool pf = false;
  for (int t = bid; t < 64 * 8; t += nb) {
    int mt, nt; tile_decode(t, 8, mt, nt);
    const int m0 = mt * 256, n0 = nt * 128;
    f32x16 acc[2][2]; acc_zero(acc);
    gemm_kloop(A + (size_t)m0 * K, K, Wt + (size_t)n0 * K, K, K, acc, (u16*)smem, pf);
    pf = (t + nb < 64 * 8);
    if (pf) { int mt2, nt2; tile_decode(t + nb, 8, mt2, nt2); gemm_prefetch(A + (size_t)mt2 * 256 * K, K, Wt + (size_t)nt2 * 128 * K, K, K, (u16*)smem); }
#pragma unroll
    for (int i = 0; i < 2; ++i) {
      float tv[2][16];
#pragma unroll
      for (int j = 0; j < 2; ++j)
#pragma unroll
        for (int e = 0; e < 16; ++e) {
          const int m = m0 + wm * 64 + i * 32 + (e & 3) + 8 * (e >> 2) + 4 * h;
          tv[j][e] = xin[(size_t)m * 1024 + n0 + wn * 64 + j * 32 + r];
        }
      __builtin_amdgcn_sched_barrier(0);
#pragma unroll
      for (int j = 0; j < 2; ++j)
#pragma unroll
        for (int e = 0; e < 16; ++e) {
          const int m = m0 + wm * 64 + i * 32 + (e & 3) + 8 * (e >> 2) + 4 * h;
          xr[(size_t)m * 1024 + n0 + wn * 64 + j * 32 + r] = acc[i][j][e] + tv[j][e];
        }
      __builtin_amdgcn_sched_barrier(0);
    }
  }
}

__device__ __forceinline__ void ph_ffnup(const Params& p, unsigned char* smem, int bid, int nb) {
  const u16* Hf = (const u16*)(p.ws + R_HF);
  const u16* Wt = (const u16*)(p.ws + R_W) + WO_GU;
  u16* act = (u16*)(p.ws + R_ACT);
  const int lane = opaque_tid() & 63, wave = opaque_tid() >> 6, wm = wave >> 1, wn = wave & 1, r = lane & 31, h = lane >> 5;
  constexpr int NT = 5632 / 128;
  bool pf = false;
  for (int t = bid; t < 64 * NT; t += nb) {
    int mt, nt; tile_decode(t, NT, mt, nt);
    const int m0 = mt * 256, n0 = nt * 128;
    f32x16 acc[2][2]; acc_zero(acc);
    gemm_kloop(Hf + (size_t)m0 * 1024, 1024, Wt + (size_t)n0 * 1024, 1024, 1024, acc, (u16*)smem, pf);
    pf = (t + nb < 64 * NT);
    if (pf) { int mt2, nt2; tile_decode(t + nb, NT, mt2, nt2); gemm_prefetch(Hf + (size_t)mt2 * 256 * 1024, 1024, Wt + (size_t)nt2 * 128 * 1024, 1024, 1024, (u16*)smem); }
    const int col = ((n0 + wn * 64) >> 6) * 32 + r;
#pragma unroll
    for (int i = 0; i < 2; ++i)
#pragma unroll
      for (int e = 0; e < 16; ++e) {
        const int m = m0 + wm * 64 + i * 32 + (e & 3) + 8 * (e >> 2) + 4 * h;
        const float gt = acc[i][0][e], up = acc[i][1][e];
        act[(size_t)m * DFF + col] = f2bf(gt * sigmoidf_(gt) * up);
      }
  }
}

#define XB_XCNT(j)  (256  + 64 * (j))
#define XB_XSUB(j)  (1280 + 64 * (j))
#define XB_XGEN(j)  (2304 + 64 * (j))
#define XB_TOP      3328
#define XB_TOPGEN   3392
#define XCD_BAR_WORDS 3456
__device__ __forceinline__ unsigned xb_ld(unsigned* q) { return __hip_atomic_load(q, __ATOMIC_RELAXED, __HIP_MEMORY_SCOPE_AGENT); }
__device__ __forceinline__ unsigned xb_add(unsigned* q, unsigned v) { return __hip_atomic_fetch_add(q, v, __ATOMIC_RELAXED, __HIP_MEMORY_SCOPE_AGENT); }
__device__ __forceinline__ unsigned xb_xcc_id() { return (unsigned)__builtin_amdgcn_s_getreg((3 << 11) | 20) & 0xFu; }
__device__ __forceinline__ void xcd_grid_barrier(unsigned* bar, volatile unsigned* st, unsigned xcc, unsigned G) {
  asm volatile("s_waitcnt vmcnt(0)" ::: "memory");
  __syncthreads();
  if (opaque_tid() == 0) {
    __builtin_amdgcn_s_waitcnt(0);
    unsigned nloc = st[0], nx = st[1];
    if (nloc == 0u) {
      for (;;) {
        unsigned sum = 0u, cnt = 0u, mine = 0u;
#pragma unroll
        for (unsigned j = 0; j < 16; ++j) { const unsigned c = xb_ld(&bar[XB_XCNT(j)]); sum += c; cnt += (c > 0u) ? 1u : 0u; mine = (j == xcc) ? c : mine; }
        if (sum == G) { nloc = mine; nx = cnt; break; }
        __builtin_amdgcn_s_sleep(1);
      }
      st[0] = nloc; st[1] = nx;
    }
    const unsigned old = xb_add(&bar[XB_XSUB(xcc)], 1u);
    const unsigned gen = old / nloc;
    if (old + 1u == (gen + 1u) * nloc) {
      __builtin_amdgcn_fence(__ATOMIC_RELEASE, "agent");
      asm volatile("s_waitcnt vmcnt(0)" ::: "memory");
      const unsigned og = xb_add(&bar[XB_TOP], 1u);
      const unsigned tg = og / nx;
      if (og + 1u == (tg + 1u) * nx) xb_add(&bar[XB_TOPGEN], 1u);
      else while (xb_ld(&bar[XB_TOPGEN]) == tg) __builtin_amdgcn_s_sleep(1);
      __builtin_amdgcn_fence(__ATOMIC_ACQUIRE, "agent");
      xb_add(&bar[XB_XGEN(xcc)], 1u);
      asm volatile("s_waitcnt vmcnt(0)" ::: "memory");
    } else {
      while (xb_ld(&bar[XB_XGEN(xcc)]) == gen) __builtin_amdgcn_s_sleep(1);
      __builtin_amdgcn_fence(__ATOMIC_ACQUIRE, "agent");
      asm volatile("s_waitcnt vmcnt(0)" ::: "memory");
    }
  }
  __syncthreads();
}
#ifndef ONLY
#define ONLY -1
#endif
#define PH_ON(q) (ONLY < 0 || ONLY == (q))
constexpr int PH_PER_LAYER = 13;
constexpr int N_PHASES = 2 * PH_PER_LAYER + 1;

__global__ void __launch_bounds__(NTHR) fwd_kernel(Params p) {
  extern __shared__ __attribute__((aligned(16))) unsigned char smem[];
  const int bid = blockIdx.x, nb = gridDim.x;
  __shared__ unsigned xb_st[4];
  unsigned* xbar = (unsigned*)(p.ws + WS_CTR);
  const unsigned xcc = xb_xcc_id();
  if (opaque_tid() == 0) { xb_st[0] = 0u; xb_st[1] = 0u; (void)xb_add(&xbar[XB_XCNT(xcc)], 1u); }
  __syncthreads();
  for (int pi = 0; pi < p.nph; ++pi) {
    if (pi == 1) { cg::this_grid().sync(); }
    else if (pi > 1) { xcd_grid_barrier(xbar, xb_st, xcc, (unsigned)nb); }
    const int wave = opaque_tid() >> 6;
    const unsigned long long cw = pi < 12 ? p.code[0] : (pi < 24 ? p.code[1] : (pi < 36 ? p.code[2] : p.code[3]));
    const int pc_ = (int)((cw >> (5 * (pi % 12))) & 31);
    if (pc_ == 27) continue;
    if (pc_ == 26) {
      ph_rmsnorm(p.out, p.in[I_NORM_FINAL], nullptr, p.out, bid * 8 + wave, nb * 8);
      continue;
    }
    const int l = pc_ / PH_PER_LAYER, q = pc_ % PH_PER_LAYER;
    const float* xin = (l == 0) ? p.in[I_X] : p.out;
    switch (q) {
      case 0:
        if (PH_ON(0)) {
          ph_convert(p, l, smem, bid, nb, 0);
          ph_rmsnorm(xin, p.in[I_NORM_MIX] + l * 1024, (u16*)(p.ws + R_H), nullptr, bid * 8 + wave, nb * 8);
        }
        break;
      case 1: if (PH_ON(1)) { ph_inproj(p, l, smem, bid, nb); } break;
      case 2: if (PH_ON(2)) { ph_mixerA(p, l, smem, bid, nb); } break;
      case 3: if (PH_ON(3)) { ph_attn(p, l, smem, bid, nb); } break;
      case 4: if (PH_ON(4)) { ph_prep(p, l, smem, bid, nb); } break;
      case 5: if (PH_ON(5)) { ph_prep2(p, l, smem, bid, nb); } break;
      case 6: if (PH_ON(6)) { ph_scan2(p, l, smem, bid, nb); } break;
      case 7: if (PH_ON(7)) { ph_post(p, l, xin, bid, nb); } break;
      case 8: if (PH_ON(8)) { ph_merge(p, l, smem, bid, nb); } break;
      case 9: if (PH_ON(9)) { ph_resgemm((const u16*)(p.ws + R_MERGED), 1024, (const u16*)(p.ws + R_W) + WO_OUT, xin, p.out, smem, bid, nb); } break;
      case 10:
        if (PH_ON(10)) {
          ph_convert(p, l, smem, bid, nb, 1);
          ph_rmsnorm(p.out, p.in[I_NORM_FFN] + l * 1024, (u16*)(p.ws + R_HF), nullptr, bid * 8 + wave, nb * 8);
        }
        break;
      case 11: if (PH_ON(11)) { ph_ffnup(p, smem, bid, nb); } break;
      case 12: if (PH_ON(12)) { ph_resgemm((const u16*)(p.ws + R_ACT), DFF, (const u16*)(p.ws + R_W) + WO_DN, p.out, p.out, smem, bid, nb); } break;
    }
  }
}

extern "C" void kernel_launch(void* const* d_in, const int* in_sizes, int n_in, void* d_out, int out_size, void* d_ws, size_t ws_size,
                              hipStream_t stream) {
  static int grid = 0;
  if (grid == 0) {
    if (n_in != 31 || ws_size < WS_END) { fprintf(stderr, "kernel_launch: unexpected n_in %d / ws_size %zu (need %zu)\n", n_in, ws_size, (size_t)WS_END); grid = -1; return; }
    int dev = 0, cus = 0, per_cu = 0;
    hipGetDevice(&dev);
    hipDeviceGetAttribute(&cus, hipDeviceAttributeMultiprocessorCount, dev);
    hipFuncSetAttribute((const void*)fwd_kernel, hipFuncAttributeMaxDynamicSharedMemorySize, LDS_BYTES);
    hipOccupancyMaxActiveBlocksPerMultiprocessor(&per_cu, (const void*)fwd_kernel, NTHR, LDS_BYTES);
    if (per_cu < 1) per_cu = 1;
    grid = cus * per_cu;
    if (grid > 256) grid = 256;
  }
  if (grid < 0) return;
  Params p{};
  for (int i = 0; i < 31; ++i) p.in[i] = (const float*)d_in[i];
  p.out = (float*)d_out; p.ws = (unsigned char*)d_ws;
  {
    int list[48]; int n = 0;
    for (int ph = 0; ph < N_PHASES; ++ph) {
      list[n++] = ph;
#ifdef REPQ
      if (ph < N_PHASES - 1 && (ph % PH_PER_LAYER) == REPQ) list[n++] = ph;
#endif
    }
#ifdef REPSYNC
    for (int i = 0; i < REPSYNC; ++i) list[n++] = 27;
#endif
    for (int i = 0; i < n; ++i) p.code[i / 12] |= (unsigned long long)list[i] << (5 * (i % 12));
    p.nph = n;
  }
  (void)hipMemsetAsync((unsigned char*)d_ws + WS_CTR, 0, 16384, stream);
  void* args[] = {&p};
  hipError_t e = hipLaunchCooperativeKernel((const void*)fwd_kernel, dim3(grid), dim3(NTHR), args, LDS_BYTES, stream);
  if (e != hipSuccess) fprintf(stderr, "cooperative launch failed: %s (grid %d)\n", hipGetErrorString(e), grid);
}
```

```cpp
#include <hip/hip_runtime.h>
#include <hip/hip_cooperative_groups.h>
#include <cstdio>
namespace cg = cooperative_groups;

#ifndef COOP
#define COOP 1
#endif

typedef unsigned short u16;
typedef unsigned int u32;
using bf16x8 = __attribute__((ext_vector_type(8))) short;
using f32x16 = __attribute__((ext_vector_type(16))) float;

constexpr int T = 16384;
constexpr int S = 8192;
constexpr int DM = 1024;
constexpr int IN_COLS = 8456;
constexpr int NPAD_IN = 8576;
constexpr int NMIX = 5504;
constexpr int DFF = 2816;
constexpr int NTHR = 512;

constexpr size_t U = 16777216;
constexpr size_t R_H = 0;
constexpr size_t R_UA = 2 * U;
constexpr size_t R_VA = 4 * U;
constexpr size_t R_Q = 6 * U;
constexpr size_t R_K = 7 * U;
constexpr size_t R_V = 8 * U;
constexpr size_t R_PC = 9 * U;
constexpr size_t R_LOGF = 12 * U + U / 2;
constexpr size_t R_CUM = R_LOGF + 524288;
constexpr size_t R_W = R_CUM + 524288;
constexpr size_t R_YB = 0;
constexpr size_t RW_R = 6 * U, RW_W = U, RW_K = 4 * U, RW_V = 5 * U, RW_A = 7 * U, RW_G = 8 * U;
constexpr size_t R_YC = U, R_H2 = 10 * U, R_MERGED = 7 * U;
constexpr size_t R_HF = 2 * U, R_ACT = 4 * U;
constexpr size_t WO_IN = 0;
constexpr size_t WO_PA = WO_IN + (size_t)NPAD_IN * 1024;
constexpr size_t WO_PB = WO_PA + 1024 * 1024;
constexpr size_t WO_PC = WO_PB + 1024 * 512;
constexpr size_t WO_OUT = WO_PC + 1024 * 512;
constexpr size_t WO_GU = WO_OUT + 1024 * 1024;
constexpr size_t WO_DN = WO_GU + (size_t)5632 * 1024;
constexpr size_t WO_WUP = WO_DN + (size_t)1024 * 2816;
constexpr size_t WO_AUP = WO_WUP + 512 * 64;
constexpr size_t WO_GUP = WO_AUP + 512 * 64;
constexpr size_t WO_VDN = WO_GUP + 512 * 128;
constexpr size_t WO_VUP = WO_VDN + 32 * 512;
constexpr size_t WO_END = WO_VUP + 512 * 64;
constexpr size_t R_VF = R_W + WO_END * 2;
constexpr size_t WS_CTR = R_VF + U;
constexpr size_t WS_END = WS_CTR + 16384;

constexpr int LDS_BYTES = 147456;

struct Params {
  const float* in[31];
  float* out;
  unsigned char* ws;
  unsigned long long code[4];
  int nph, pad;
};

enum { I_X = 0, I_NORM_MIX, I_W_IN, I_GATE_BIAS, I_A_LN_G, I_A_LN_B, I_A_W_S, I_A_B_S, I_B_F_BIAS, I_C_MU, I_C_W0, I_C_W_UP,
       I_C_A0, I_C_A_UP, I_C_G_UP, I_C_K_K, I_C_K_A, I_C_R_K, I_C_LNX_G, I_C_LNX_B, I_C_V0, I_C_V_DOWN, I_C_V_UP, I_P_A, I_P_B,
       I_P_C, I_W_OUT, I_NORM_FFN, I_W_GATE_UP, I_W_DOWN, I_NORM_FINAL };

__device__ __forceinline__ int opaque_tid() { int t = (int)__builtin_amdgcn_workitem_id_x(); asm volatile("" : "+v"(t)); return t; }
typedef __bf16 bf16x2_t __attribute__((ext_vector_type(2)));
typedef float f32x2_t __attribute__((ext_vector_type(2)));
__device__ __forceinline__ u32 pk2(float a, float b) {
  f32x2_t v = {a, b};
  return __builtin_bit_cast(u32, __builtin_convertvector(v, bf16x2_t));
}
__device__ __forceinline__ u16 f2bf(float f) { return (u16)(pk2(f, 0.f) & 0xffffu); }
__device__ __forceinline__ float bf2f(u16 h) { return __uint_as_float(((u32)h) << 16); }
__device__ __forceinline__ float bflo(u32 w) { return __uint_as_float(w << 16); }
__device__ __forceinline__ float bfhi(u32 w) { return __uint_as_float(w & 0xffff0000u); }
__device__ __forceinline__ float sigmoidf_(float x) { return __builtin_amdgcn_rcpf(1.f + __expf(-x)); }
__device__ __forceinline__ float gelu_tanh(float x) {
  float u = 0.7978845608028654f * (x + 0.044715f * x * x * x);
  return x * __builtin_amdgcn_rcpf(1.f + __expf(-2.f * u));
}
__device__ __forceinline__ float softplusf_(float x) { return fmaxf(x, 0.f) + __logf(1.f + __expf(-fabsf(x))); }
__device__ __forceinline__ float wave_sum(float v) {
#pragma unroll
  for (int o = 1; o < 64; o <<= 1) v += __shfl_xor(v, o);
  return v;
}
__device__ __forceinline__ float row16_sum(float v) {
  v += __int_as_float(__builtin_amdgcn_update_dpp(0, __float_as_int(v), 0xB1, 0xF, 0xF, false));
  v += __int_as_float(__builtin_amdgcn_update_dpp(0, __float_as_int(v), 0x4E, 0xF, 0xF, false));
  v += __int_as_float(__builtin_amdgcn_update_dpp(0, __float_as_int(v), 0x141, 0xF, 0xF, false));
  v += __int_as_float(__builtin_amdgcn_update_dpp(0, __float_as_int(v), 0x140, 0xF, 0xF, false));
  return v;
}

__device__ __forceinline__ float wave_sum_fast(float v) {
  v = row16_sum(v);
  const float s0 = __int_as_float(__builtin_amdgcn_readlane(__float_as_int(v), 0));
  const float s1 = __int_as_float(__builtin_amdgcn_readlane(__float_as_int(v), 16));
  const float s2 = __int_as_float(__builtin_amdgcn_readlane(__float_as_int(v), 32));
  const float s3 = __int_as_float(__builtin_amdgcn_readlane(__float_as_int(v), 48));
  return (s0 + s1) + (s2 + s3);
}
__device__ __forceinline__ int map_col(int kind, int np) {
  if (kind == 0) return np;
  if (kind == 1) { return np < 3592 ? np : (np < 3712 ? -1 : np - 120); }
  int grp = np >> 6, jj = np & 63;
  return jj < 32 ? 32 * grp + jj : DFF + 32 * grp + (jj - 32);
}
__device__ __forceinline__ void conv_item(const float* W, int K, int Nsrc, int Ndst, int kind, u16* Wt, float* scr, int item, int lane, int Kvalid = 1 << 30) {
  const int nblk = Ndst / 32, kb = item / nblk, nb = item % nblk, k0 = 64 * kb, n0 = 32 * nb;
  const int n = map_col(kind, n0 + (lane & 31));
  float tmpw[32];
#pragma unroll
  for (int i = 0; i < 32; ++i) {
    const int kk = 2 * i + (lane >> 5);
    tmpw[i] = (n >= 0 && k0 + kk < Kvalid) ? W[(size_t)(k0 + kk) * Nsrc + n] : 0.f;
  }
  __builtin_amdgcn_sched_barrier(0);
#pragma unroll
  for (int i = 0; i < 32; ++i) scr[(2 * i + (lane >> 5)) * 33 + (lane & 31)] = tmpw[i];
  __builtin_amdgcn_wave_barrier();
  __builtin_amdgcn_s_waitcnt(0xc07f);
  const int c = lane & 7;
#pragma unroll
  for (int j = 0; j < 4; ++j) {
    const int nn = (lane >> 3) + 8 * j;
    const float* s = scr + (8 * c) * 33 + nn;
    uint4 o;
    o.x = pk2(s[0 * 33], s[1 * 33]); o.y = pk2(s[2 * 33], s[3 * 33]); o.z = pk2(s[4 * 33], s[5 * 33]); o.w = pk2(s[6 * 33], s[7 * 33]);
    *(uint4*)(Wt + (size_t)(n0 + nn) * K + k0 + 8 * c) = o;
  }
  __builtin_amdgcn_wave_barrier();
  __builtin_amdgcn_s_waitcnt(0xc07f);
}

__device__ __forceinline__ void ph_convert(const Params& p, int l, unsigned char* smem, int bid, int nb, int part) {
  const int lane = opaque_tid() & 63, wave = opaque_tid() >> 6;
  float* scr = (float*)smem + wave * (64 * 33);
  u16* Wb = (u16*)(p.ws + R_W);
  const int gw = bid * 8 + wave, ngw = nb * 8;
  constexpr int I0 = 16 * (NPAD_IN / 32), I1 = 16 * 32, I2 = 8 * 32, I3 = 8 * 32, I4 = 16 * 32, I5 = 16 * (5632 / 32), I6 = 44 * 32;
  if (part == 0) {
    constexpr int NA = I0 + I1 + I2 + I3 + I4 + 16 + 16 + 32 + 8 + 16;
    for (int it = gw; it < NA; it += ngw) {
      int r = it;
      if (r < I0) { conv_item(p.in[I_W_IN] + (size_t)l * 1024 * IN_COLS, 1024, IN_COLS, NPAD_IN, 1, Wb + WO_IN, scr, r, lane); continue; } r -= I0;
      if (r < I1) { conv_item(p.in[I_P_A] + (size_t)l * 1024 * 1024, 1024, 1024, 1024, 0, Wb + WO_PA, scr, r, lane); continue; } r -= I1;
      if (r < I2) { conv_item(p.in[I_P_B] + (size_t)l * 512 * 1024, 512, 1024, 1024, 0, Wb + WO_PB, scr, r, lane); continue; } r -= I2;
      if (r < I3) { conv_item(p.in[I_P_C] + (size_t)l * 512 * 1024, 512, 1024, 1024, 0, Wb + WO_PC, scr, r, lane); continue; } r -= I3;
      if (r < I4) { conv_item(p.in[I_W_OUT] + (size_t)l * 1024 * 1024, 1024, 1024, 1024, 0, Wb + WO_OUT, scr, r, lane); continue; } r -= I4;
      if (r < 16) { conv_item(p.in[I_C_W_UP] + (size_t)l * 64 * 512, 64, 512, 512, 0, Wb + WO_WUP, scr, r, lane); continue; } r -= 16;
      if (r < 16) { conv_item(p.in[I_C_A_UP] + (size_t)l * 64 * 512, 64, 512, 512, 0, Wb + WO_AUP, scr, r, lane); continue; } r -= 16;
      if (r < 32) { conv_item(p.in[I_C_G_UP] + (size_t)l * 128 * 512, 128, 512, 512, 0, Wb + WO_GUP, scr, r, lane); continue; } r -= 32;
      if (l == 0) continue;
      if (r < 8) { conv_item(p.in[I_C_V_DOWN] + (size_t)(l - 1) * 512 * 32, 512, 32, 32, 0, Wb + WO_VDN, scr, r, lane); continue; } r -= 8;
      conv_item(p.in[I_C_V_UP] + (size_t)(l - 1) * 32 * 512, 64, 512, 512, 0, Wb + WO_VUP, scr, r, lane, 32);
    }
  } else {
    for (int it = gw; it < I5 + I6; it += ngw) {
      int r = it;
      if (r < I5) { conv_item(p.in[I_W_GATE_UP] + (size_t)l * 1024 * 5632, 1024, 5632, 5632, 2, Wb + WO_GU, scr, r, lane); continue; } r -= I5;
      conv_item(p.in[I_W_DOWN] + (size_t)l * DFF * 1024, DFF, 1024, 1024, 0, Wb + WO_DN, scr, r, lane);
    }
  }
}

__device__ __forceinline__ void ph_rmsnorm(const float* src, const float* g, u16* dst, float* dstf, int widx, int nw) {
  const int lane = opaque_tid() & 63;
  float4 gg[4];
#pragma unroll
  for (int j = 0; j < 4; ++j) gg[j] = *(const float4*)(g + 4 * lane + 256 * j);
  for (int row0 = widx; row0 < T; row0 += 4 * nw) {
    float4 v[4][4];
#pragma unroll
    for (int u = 0; u < 4; ++u) {
      const int row = (row0 + u * nw < T) ? row0 + u * nw : widx;
#pragma unroll
      for (int j = 0; j < 4; ++j) v[u][j] = *(const float4*)(src + (size_t)row * 1024 + 4 * lane + 256 * j);
    }
    __builtin_amdgcn_sched_barrier(0);
#pragma unroll
    for (int u = 0; u < 4; ++u) {
      const int row = row0 + u * nw;
      float s = 0.f;
#pragma unroll
      for (int j = 0; j < 4; ++j) s += (v[u][j].x * v[u][j].x + v[u][j].y * v[u][j].y) + (v[u][j].z * v[u][j].z + v[u][j].w * v[u][j].w);
      s = wave_sum_fast(s);
      const float rs = rsqrtf(s * (1.f / 1024.f) + 1e-6f);
      if (row < T) {
#pragma unroll
        for (int j = 0; j < 4; ++j) {
          const float a = v[u][j].x * rs * gg[j].x, b2 = v[u][j].y * rs * gg[j].y, c = v[u][j].z * rs * gg[j].z, d = v[u][j].w * rs * gg[j].w;
          if (dstf) *(float4*)(dstf + (size_t)row * 1024 + 4 * lane + 256 * j) = make_float4(a, b2, c, d);
          else { uint2 o; o.x = pk2(a, b2); o.y = pk2(c, d); *(uint2*)(dst + (size_t)row * 1024 + 4 * lane + 256 * j) = o; }
        }
      }
    }
  }
}

constexpr int LROW = 72;
constexpr int STAGE_ELEMS = (256 + 128) * LROW;

typedef unsigned int v4u __attribute__((ext_vector_type(4)));
struct GkRegs { v4u a0, a1, a2, a3, b0, b1; };
#define GK_LOAD(R, KT)                                                          \
  {                                                                             \
    const u16* pa_ = A + (size_t)lrow * lda + (KT) * 64 + lkc;                  \
    const u16* pb_ = B + (size_t)lrow * ldb + (KT) * 64 + lkc;                  \
    R.a0 = *(const v4u*)(pa_);                                                \
    R.a1 = *(const v4u*)(pa_ + (size_t)64 * lda);                             \
    R.a2 = *(const v4u*)(pa_ + (size_t)128 * lda);                            \
    R.a3 = *(const v4u*)(pa_ + (size_t)192 * lda);                            \
    R.b0 = *(const v4u*)(pb_);                                                \
    R.b1 = *(const v4u*)(pb_ + (size_t)64 * ldb);                             \
  }
#define GK_WRITE(R, BUF)                                                        \
  {                                                                             \
    u16* wa_ = smem + (BUF) * STAGE_ELEMS + lrow * LROW + lkc;                  \
    u16* wb_ = wa_ + 256 * LROW;                                                \
    *(v4u*)(wa_) = R.a0;                                                      \
    *(v4u*)(wa_ + 64 * LROW) = R.a1;                                          \
    *(v4u*)(wa_ + 128 * LROW) = R.a2;                                         \
    *(v4u*)(wa_ + 192 * LROW) = R.a3;                                         \
    *(v4u*)(wb_) = R.b0;                                                      \
    *(v4u*)(wb_ + 64 * LROW) = R.b1;                                          \
  }
#define GK_COMPUTE(BUF)                                                                                                 \
  {                                                                                                                     \
    const u16* sa_ = smem + (BUF) * STAGE_ELEMS; const u16* sb_ = sa_ + 256 * LROW;                                     \
    _Pragma("unroll") for (int s = 0; s < 4; ++s) {                                                                     \
      bf16x8 af[2], bfr[2];                                                                                             \
      _Pragma("unroll") for (int i = 0; i < 2; ++i) af[i] = *(const bf16x8*)(sa_ + (wm * 64 + i * 32 + r) * LROW + s * 16 + h * 8);  \
      _Pragma("unroll") for (int j = 0; j < 2; ++j) bfr[j] = *(const bf16x8*)(sb_ + (wn * 64 + j * 32 + r) * LROW + s * 16 + h * 8); \
      _Pragma("unroll") for (int i = 0; i < 2; ++i) _Pragma("unroll") for (int j = 0; j < 2; ++j)                       \
        acc[i][j] = __builtin_amdgcn_mfma_f32_32x32x16_bf16(af[i], bfr[j], acc[i][j], 0, 0, 0);                         \
    }                                                                                                                   \
  }
#ifndef GEMM_DMA
#define GEMM_DMA 1
#endif
#if GEMM_DMA
constexpr int DS_A = 256 * 64, DS_STAGE = (256 + 128) * 64;
__device__ __forceinline__ void gd_issue(const u16* __restrict__ A, int lda, const u16* __restrict__ B, int ldb, int kt, int st, u16* smem, int lane, int wave) {
  const int drow = lane >> 3;
  const int rowA = wave * 32 + drow, rowB = wave * 16 + drow;
  const u16* gA0 = A + (size_t)rowA * lda + (((lane & 7) ^ ((rowA >> 1) & 7)) * 8) + kt * 64;
  const u16* gA1 = A + (size_t)(rowA + 8) * lda + (((lane & 7) ^ (((rowA + 8) >> 1) & 7)) * 8) + kt * 64;
  const u16* gB0 = B + (size_t)rowB * ldb + (((lane & 7) ^ ((rowB >> 1) & 7)) * 8) + kt * 64;
  const u16* gB1 = B + (size_t)(rowB + 8) * ldb + (((lane & 7) ^ (((rowB + 8) >> 1) & 7)) * 8) + kt * 64;
  u16* sA_ = smem + st * DS_STAGE + wave * 32 * 64;
  u16* sB_ = smem + st * DS_STAGE + DS_A + wave * 16 * 64;
  __builtin_amdgcn_global_load_lds((const unsigned*)(gA0), (unsigned*)(sA_), 16, 0, 0);
  __builtin_amdgcn_global_load_lds((const unsigned*)(gA1), (unsigned*)(sA_ + 8 * 64), 16, 0, 0);
  __builtin_amdgcn_global_load_lds((const unsigned*)(gA0 + (size_t)16 * lda), (unsigned*)(sA_ + 16 * 64), 16, 0, 0);
  __builtin_amdgcn_global_load_lds((const unsigned*)(gA1 + (size_t)16 * lda), (unsigned*)(sA_ + 24 * 64), 16, 0, 0);
  __builtin_amdgcn_global_load_lds((const unsigned*)(gB0), (unsigned*)(sB_), 16, 0, 0);
  __builtin_amdgcn_global_load_lds((const unsigned*)(gB1), (unsigned*)(sB_ + 8 * 64), 16, 0, 0);
}
__device__ __forceinline__ void gemm_prefetch(const u16* __restrict__ A, int lda, const u16* __restrict__ B, int ldb, int K, u16* smem) {
  const int tid = opaque_tid(), lane = tid & 63, wave = __builtin_amdgcn_readfirstlane(tid >> 6);
  gd_issue(A, lda, B, ldb, 0, 0, smem, lane, wave);
  gd_issue(A, lda, B, ldb, (K > 64 ? 1 : 0), 1, smem, lane, wave);
}
__device__ __forceinline__ void gemm_kloop(const u16* __restrict__ A, int lda, const u16* __restrict__ B, int ldb, int K,
                                           f32x16 (&acc)[2][2], u16* smem, bool prefetched = false, bool pipe = true) {
  const int tid = opaque_tid(), lane = tid & 63, wave = __builtin_amdgcn_readfirstlane(tid >> 6);
  const int wm = wave >> 1, wn = wave & 1, r = lane & 31, h = lane >> 5;
  const int nk = K >> 6;
  const int key = (r >> 1) & 7;
  if (!prefetched) {
    gd_issue(A, lda, B, ldb, 0, 0, smem, lane, wave);
    gd_issue(A, lda, B, ldb, (nk > 1 ? 1 : 0), 1, smem, lane, wave);
  }
  int st = 0;
  for (int kt = 0; kt < nk; ++kt) {
    __builtin_amdgcn_sched_barrier(0);
    if (kt + 1 < nk) asm volatile("s_waitcnt vmcnt(6)" ::: "memory"); else asm volatile("s_waitcnt vmcnt(0)" ::: "memory");
    __builtin_amdgcn_s_barrier();
    __builtin_amdgcn_sched_barrier(0);
    if (kt + 2 < nk) {
      const int st2 = (st >= 1) ? st - 1 : 2;
      gd_issue(A, lda, B, ldb, kt + 2, st2, smem, lane, wave);
    }
    const u16* sa_ = smem + st * DS_STAGE + (wm * 64 + r) * 64;
    const u16* sb_ = smem + st * DS_STAGE + DS_A + (wn * 64 + r) * 64;
    if (pipe) {
    bf16x8 af[2][2], bfr[2][2];
    {
      const int co = ((0 + h) ^ key) * 8;
#pragma unroll
      for (int i = 0; i < 2; ++i) af[0][i] = *(const bf16x8*)(sa_ + i * 32 * 64 + co);
#pragma unroll
      for (int j = 0; j < 2; ++j) bfr[0][j] = *(const bf16x8*)(sb_ + j * 32 * 64 + co);
    }
#pragma unroll
    for (int s4 = 0; s4 < 4; ++s4) {
      if (s4 < 3) {
        const int co = ((2 * (s4 + 1) + h) ^ key) * 8;
#pragma unroll
        for (int i = 0; i < 2; ++i) af[(s4 + 1) & 1][i] = *(const bf16x8*)(sa_ + i * 32 * 64 + co);
#pragma unroll
        for (int j = 0; j < 2; ++j) bfr[(s4 + 1) & 1][j] = *(const bf16x8*)(sb_ + j * 32 * 64 + co);
      }
#pragma unroll
      for (int i = 0; i < 2; ++i)
#pragma unroll
        for (int j = 0; j < 2; ++j) acc[i][j] = __builtin_amdgcn_mfma_f32_32x32x16_bf16(af[s4 & 1][i], bfr[s4 & 1][j], acc[i][j], 0, 0, 0);
    }
    __builtin_amdgcn_sched_group_barrier(0x100, 8, 0);
    __builtin_amdgcn_sched_group_barrier(0x008, 4, 0);
    __builtin_amdgcn_sched_group_barrier(0x100, 4, 0);
    __builtin_amdgcn_sched_group_barrier(0x008, 4, 0);
    __builtin_amdgcn_sched_group_barrier(0x100, 4, 0);
    __builtin_amdgcn_sched_group_barrier(0x008, 8, 0);
    } else {
#pragma unroll
      for (int s4 = 0; s4 < 4; ++s4) {
        const int co = ((2 * s4 + h) ^ key) * 8;
        bf16x8 af1[2], bfr1[2];
#pragma unroll
        for (int i = 0; i < 2; ++i) af1[i] = *(const bf16x8*)(sa_ + i * 32 * 64 + co);
#pragma unroll
        for (int j = 0; j < 2; ++j) bfr1[j] = *(const bf16x8*)(sb_ + j * 32 * 64 + co);
#pragma unroll
        for (int i = 0; i < 2; ++i)
#pragma unroll
          for (int j = 0; j < 2; ++j) acc[i][j] = __builtin_amdgcn_mfma_f32_32x32x16_bf16(af1[i], bfr1[j], acc[i][j], 0, 0, 0);
      }
    }
    st = (st == 2) ? 0 : st + 1;
  }
  asm volatile("s_waitcnt lgkmcnt(0)" ::: "memory");
  __builtin_amdgcn_s_barrier();
}
#else
__device__ __forceinline__ void gemm_kloop(const u16* __restrict__ A, int lda, const u16* __restrict__ B, int ldb, int K,
                                           f32x16 (&acc)[2][2], u16* smem) {
  const int tid = opaque_tid(), lane = tid & 63, wave = tid >> 6;
  const int wm = wave >> 1, wn = wave & 1, r = lane & 31, h = lane >> 5;
  const int lrow = tid >> 3, lkc = (tid & 7) * 8;
  GkRegs g0, g1;
  const int nk = K >> 6;
  GK_LOAD(g0, 0)
  GK_LOAD(g1, (nk > 1 ? 1 : 0))
  GK_WRITE(g0, 0)
  __syncthreads();
  for (int kt = 0; kt < nk; kt += 2) {
    GK_LOAD(g0, (kt + 2 < nk ? kt + 2 : nk - 1))
    GK_COMPUTE(0)
    GK_WRITE(g1, 1)
    __syncthreads();
    GK_LOAD(g1, (kt + 3 < nk ? kt + 3 : nk - 1))
    GK_COMPUTE(1)
    GK_WRITE(g0, 0)
    __syncthreads();
  }
}
#endif
__device__ __forceinline__ void acc_zero(f32x16 (&acc)[2][2]) {
#pragma unroll
  for (int i = 0; i < 2; ++i)
#pragma unroll
    for (int j = 0; j < 2; ++j)
#pragma unroll
      for (int e = 0; e < 16; ++e) acc[i][j][e] = 0.f;
}
__device__ __forceinline__ void tile_decode(int t, int NT, int& mt, int& nt) {
  const int g = t / (16 * NT), rem = t % (16 * NT);
  nt = rem / 16; mt = g * 16 + (rem % 16);
}
#define EPI_LOOP(i, j, e) \
  _Pragma("unroll") for (int i = 0; i < 2; ++i) _Pragma("unroll") for (int j = 0; j < 2; ++j) _Pragma("unroll") for (int e = 0; e < 16; ++e)

__device__ __forceinline__ void ph_inproj(const Params& p, int l, unsigned char* smem, int bid, int nb) {
  const u16* H = (const u16*)(p.ws + R_H);
  const u16* Wt = (const u16*)(p.ws + R_W) + WO_IN;
  const int lane = opaque_tid() & 63, wave = opaque_tid() >> 6, wm = wave >> 1, wn = wave & 1, r = lane & 31, h = lane >> 5;
  constexpr int NT = NMIX / 128;
  bool pf = false;
  for (int t = bid; t < 64 * NT; t += nb) {
    int mt, nt; tile_decode(t, NT, mt, nt);
    const int m0 = mt * 256, n0 = nt * 128;
    f32x16 acc[2][2]; acc_zero(acc);
    gemm_kloop(H + (size_t)m0 * 1024, 1024, Wt + (size_t)n0 * 1024, 1024, 1024, acc, (u16*)smem, pf);
    pf = (t + nb < 64 * NT);
    if (pf) { int mt2, nt2; tile_decode(t + nb, NT, mt2, nt2); gemm_prefetch(H + (size_t)mt2 * 256 * 1024, 1024, Wt + (size_t)nt2 * 128 * 1024, 1024, 1024, (u16*)smem); }
    if (n0 < 2048) {
      u16* dst = (u16*)(p.ws + (n0 < 1024 ? R_UA : R_VA));
      const int nb0 = (n0 & 1023) + wn * 64 + r;
      EPI_LOOP(i, j, e) {
        const int m = m0 + wm * 64 + i * 32 + (e & 3) + 8 * (e >> 2) + 4 * h;
        dst[(size_t)m * 1024 + nb0 + j * 32] = f2bf(gelu_tanh(acc[i][j][e]));
      }
    } else if (n0 < 3584) {
      const int seg = (n0 - 2048) >> 9;
      u16* dst = (u16*)(p.ws + (seg == 0 ? R_Q : (seg == 1 ? R_K : R_V)));
      const int nb0 = ((n0 - 2048) & 511) + wn * 64 + r;
      EPI_LOOP(i, j, e) {
        const int m = m0 + wm * 64 + i * 32 + (e & 3) + 8 * (e >> 2) + 4 * h;
        dst[(size_t)m * 512 + nb0 + j * 32] = f2bf(acc[i][j][e]);
      }
    } else if (n0 < 3712) {
      if (wn == 0 && r < 8) {
        float* dst = (float*)(p.ws + R_LOGF);
        const float bfv = p.in[I_B_F_BIAS][l * 8 + r];
#pragma unroll
        for (int i = 0; i < 2; ++i)
#pragma unroll
          for (int e = 0; e < 16; ++e) {
            const int m = m0 + wm * 64 + i * 32 + (e & 3) + 8 * (e >> 2) + 4 * h;
            const float z = acc[i][0][e] + bfv;
            dst[(size_t)m * 8 + r] = -softplusf_(-z);
          }
      }
    } else {
      u16* dst = (u16*)(p.ws + R_PC);
      const int nb0 = (n0 - 3712) + wn * 64 + r;
      EPI_LOOP(i, j, e) {
        const int m = m0 + wm * 64 + i * 32 + (e & 3) + 8 * (e >> 2) + 4 * h;
        dst[(size_t)m * 1792 + nb0 + j * 32] = f2bf(acc[i][j][e]);
      }
    }
  }
}

constexpr int MA_ROW = 136;
__device__ __forceinline__ void mixerA_item(const Params& p, int l, unsigned char* smem, int item) {
  const int c = item >> 2, g = item & 3, tok0 = c * 128, ch0 = g * 256;
  const int tid = opaque_tid(), lane = tid & 63, wave = tid >> 6, r = lane & 31, h = lane >> 5;
  float* stats = (float*)smem;
  u16* Wm = (u16*)(smem + 1024);
  u16* Vt = Wm + 128 * MA_ROW;
  const u16* va = (const u16*)(p.ws + R_VA);
  u16* ua = (u16*)(p.ws + R_UA);
  {
    const int tok = tid >> 2, part = tid & 3;
    const u16* row = va + (size_t)(tok0 + tok) * 1024;
    float s = 0.f, s2 = 0.f;
#pragma unroll 4
    for (int i = 0; i < 32; ++i) {
      const uint4 q = *(const uint4*)(row + (i * 4 + part) * 8);
      const u32 w[4] = {q.x, q.y, q.z, q.w};
#pragma unroll
      for (int e = 0; e < 4; ++e) { const float a = bflo(w[e]), b = bfhi(w[e]); s += a + b; s2 += a * a + b * b; }
    }
    s += __shfl_xor(s, 1); s2 += __shfl_xor(s2, 1);
    s += __shfl_xor(s, 2); s2 += __shfl_xor(s2, 2);
    if (part == 0) {
      const float mu = s * (1.f / 1024.f);
      const float var = fmaxf(s2 * (1.f / 1024.f) - mu * mu, 0.f);
      stats[tok * 2] = mu; stats[tok * 2 + 1] = rsqrtf(var + 1e-5f);
    }
  }
  {
    const int t = tid >> 2, s0 = (tid & 3) * 32;
    const float* wsrc = p.in[I_A_W_S] + ((size_t)(l * 4 + g) * 128 + t) * 128 + s0;
#pragma unroll
    for (int q4 = 0; q4 < 4; ++q4) {
      float f[8];
      *(float4*)&f[0] = *(const float4*)(wsrc + q4 * 8);
      *(float4*)&f[4] = *(const float4*)(wsrc + q4 * 8 + 4);
#pragma unroll
      for (int e = 0; e < 8; ++e) if (s0 + q4 * 8 + e > t) f[e] = 0.f;
      uint4 o; o.x = pk2(f[0], f[1]); o.y = pk2(f[2], f[3]); o.z = pk2(f[4], f[5]); o.w = pk2(f[6], f[7]);
      *(uint4*)(Wm + t * MA_ROW + s0 + q4 * 8) = o;
    }
  }
  __syncthreads();
  {
    const float* lng = p.in[I_A_LN_G] + l * 1024 + ch0;
    const float* lnb = p.in[I_A_LN_B] + l * 1024 + ch0;
#pragma unroll
    for (int i = 0; i < 8; ++i) {
      const int cc = tid + 512 * i, tok = cc >> 5, cg8 = (cc & 31) * 8;
      const uint4 q = *(const uint4*)(va + (size_t)(tok0 + tok) * 1024 + ch0 + cg8);
      const float mu = stats[tok * 2], rs = stats[tok * 2 + 1];
      const u32 w[4] = {q.x, q.y, q.z, q.w};
#pragma unroll
      for (int e = 0; e < 4; ++e) {
        const int d0 = cg8 + 2 * e;
        const float a = (bflo(w[e]) - mu) * rs * lng[d0] + lnb[d0];
        const float b = (bfhi(w[e]) - mu) * rs * lng[d0 + 1] + lnb[d0 + 1];
        Vt[d0 * MA_ROW + tok] = f2bf(a);
        Vt[(d0 + 1) * MA_ROW + tok] = f2bf(b);
      }
    }
  }
  __syncthreads();
  f32x16 acc[4];
#pragma unroll
  for (int ti = 0; ti < 4; ++ti)
#pragma unroll
    for (int e = 0; e < 16; ++e) acc[ti][e] = 0.f;
#pragma unroll
  for (int ks = 0; ks < 8; ++ks) {
    const bf16x8 b = *(const bf16x8*)(Vt + (wave * 32 + r) * MA_ROW + ks * 16 + h * 8);
#pragma unroll
    for (int ti = 0; ti < 4; ++ti) {
      if (16 * ks <= 32 * ti + 31) {
        const bf16x8 a = *(const bf16x8*)(Wm + (ti * 32 + r) * MA_ROW + ks * 16 + h * 8);
        acc[ti] = __builtin_amdgcn_mfma_f32_32x32x16_bf16(a, b, acc[ti], 0, 0, 0);
      }
    }
  }
  {
    const float* bs = p.in[I_A_B_S] + (size_t)(l * 4 + g) * 128;
    const int ch = ch0 + wave * 32 + r;
    float uv[4][16], bsv[4][16];
#pragma unroll
    for (int ti = 0; ti < 4; ++ti)
#pragma unroll
      for (int e = 0; e < 16; ++e) {
        const int t = ti * 32 + (e & 3) + 8 * (e >> 2) + 4 * h;
        uv[ti][e] = bf2f(ua[(size_t)(tok0 + t) * 1024 + ch]);
        bsv[ti][e] = bs[t];
      }
    __builtin_amdgcn_sched_barrier(0);
#pragma unroll
    for (int ti = 0; ti < 4; ++ti)
#pragma unroll
      for (int e = 0; e < 16; ++e) {
        const int t = ti * 32 + (e & 3) + 8 * (e >> 2) + 4 * h;
        ua[(size_t)(tok0 + t) * 1024 + ch] = f2bf(uv[ti][e] * (acc[ti][e] + bsv[ti][e]));
      }
  }
  __syncthreads();
}
__device__ __forceinline__ void cumsum_item(const Params& p, unsigned char* smem, int bh) {
  const int b = bh >> 3, hh = bh & 7, tid = opaque_tid();
  const float* logf_ = (const float*)(p.ws + R_LOGF);
  float* cum = (float*)(p.ws + R_CUM) + (size_t)bh * S;
  float* part = (float*)smem;
  float v[16]; float s = 0.f;
#pragma unroll
  for (int i = 0; i < 16; ++i) { v[i] = logf_[(size_t)(b * S + tid * 16 + i) * 8 + hh]; s += v[i]; }
  part[tid] = s;
  __syncthreads();
  float pre = 0.f;
  for (int i = 0; i < tid; ++i) pre += part[i];
#pragma unroll
  for (int i = 0; i < 16; ++i) { pre += v[i]; cum[tid * 16 + i] = pre; }
  __syncthreads();
}
__device__ __forceinline__ void ph_mixerA(const Params& p, int l, unsigned char* smem, int bid, int nb) {
  for (int it = bid; it < 16; it += nb) cumsum_item(p, smem, it);
}

constexpr int AT_KROW = 72;
constexpr float AT_SKIP = 250.f;
constexpr int AT_STAGE = 64 * AT_KROW * 2 * 2 + 256;
__device__ __forceinline__ void attn_item(const Params& p, unsigned char* smem, int qb, int bh) {
  const int b = bh >> 3, hh = bh & 7;
  const int tid = opaque_tid(), lane = tid & 63, wave = tid >> 6, r = lane & 31, h = lane >> 5;
  const u16* Q = (const u16*)(p.ws + R_Q);
  const u16* Kg = (const u16*)(p.ws + R_K);
  const u16* Vg = (const u16*)(p.ws + R_V);
  u16* Yb = (u16*)(p.ws + R_YB);
  const float* cum = (const float*)(p.ws + R_CUM) + (size_t)bh * S;
  const int q0w = qb * 256 + wave * 32;
  const size_t tokq = (size_t)b * S + q0w + r;
  const float LOG2E = 1.4426950408889634f;
  const float cq0 = cum[qb * 256];
  bf16x8 qf[4];
#pragma unroll
  for (int s = 0; s < 4; ++s) qf[s] = *(const bf16x8*)(Q + tokq * 512 + hh * 64 + s * 16 + h * 8);
  f32x16 accO[2];
#pragma unroll
  for (int d = 0; d < 2; ++d)
#pragma unroll
    for (int e = 0; e < 16; ++e) accO[d][e] = 0.f;
  float mrun = -INFINITY, lrun = 0.f;
  const int nkt = 4 * (qb + 1);
  const int skey = tid >> 3, sdc = (tid & 7) * 8;
  const int vkey = tid & 63, vdc = (tid >> 6) * 8;
  uint4 rk, rv; float rc = 0.f;
  unsigned* cntw = (unsigned*)(smem + 2 * AT_STAGE);
  if (tid == 0) *cntw = 0u;
  __syncthreads();
  if (tid < nkt && (cq0 - cum[tid * 64 + 63]) * LOG2E < -AT_SKIP) atomicAdd(cntw, 1u);
  __syncthreads();
  const int kt0 = (int)*cntw;
  {
    const size_t tk = ((size_t)b * S + (nkt - 1) * 64 + skey) * 512 + hh * 64 + sdc;
    rk = *(const uint4*)(Kg + tk); rv = *(const uint4*)(Vg + ((size_t)b * S + (nkt - 1) * 64 + vkey) * 512 + hh * 64 + vdc);
    if (tid < 64) rc = cum[(nkt - 1) * 64 + tid];
  }
  auto swrite = [&](int buf) {
    u16* Ks = (u16*)(smem + buf * AT_STAGE);
    u16* Vt = Ks + 64 * AT_KROW;
    float* bias = (float*)(smem + buf * AT_STAGE + 64 * AT_KROW * 4);
    *(uint4*)(Ks + skey * AT_KROW + sdc) = rk;
    const u32 w[4] = {rv.x, rv.y, rv.z, rv.w};
#pragma unroll
    for (int e = 0; e < 4; ++e) {
      Vt[(vdc + 2 * e) * AT_KROW + vkey] = (u16)(w[e] & 0xffffu);
      Vt[(vdc + 2 * e + 1) * AT_KROW + vkey] = (u16)(w[e] >> 16);
    }
    if (tid < 64) bias[tid] = (cq0 - rc) * 8.f;
  };
  swrite((nkt - 1) & 1);
  __syncthreads();
  for (int kt = nkt - 1; kt >= kt0; --kt) {
    const bool more = (kt - 1 >= kt0);
    if (more) {
      const size_t tk = ((size_t)b * S + (kt - 1) * 64 + skey) * 512 + hh * 64 + sdc;
      rk = *(const uint4*)(Kg + tk); rv = *(const uint4*)(Vg + ((size_t)b * S + (kt - 1) * 64 + vkey) * 512 + hh * 64 + vdc);
      if (tid < 64) rc = cum[(kt - 1) * 64 + tid];
    }
    if (kt * 64 <= q0w + 31) {
      const u16* Ks = (const u16*)(smem + (kt & 1) * AT_STAGE);
      const u16* Vt = Ks + 64 * AT_KROW;
      const float* bias = (const float*)(smem + (kt & 1) * AT_STAGE + 64 * AT_KROW * 4);
      f32x16 sc[2];
#pragma unroll
      for (int sub = 0; sub < 2; ++sub) {
#pragma unroll
        for (int e4 = 0; e4 < 4; ++e4) {
          const float4 bb = *(const float4*)(bias + sub * 32 + 8 * e4 + 4 * h);
          sc[sub][e4 * 4 + 0] = bb.x; sc[sub][e4 * 4 + 1] = bb.y; sc[sub][e4 * 4 + 2] = bb.z; sc[sub][e4 * 4 + 3] = bb.w;
        }
#pragma unroll
        for (int s = 0; s < 4; ++s) {
          const bf16x8 a = *(const bf16x8*)(Ks + (sub * 32 + r) * AT_KROW + s * 16 + h * 8);
          sc[sub] = __builtin_amdgcn_mfma_f32_32x32x16_bf16(a, qf[s], sc[sub], 0, 0, 0);
        }
      }
      const bool diag = (kt * 64 + 63 > q0w);
      const int qpos = q0w + r;
      float mx = -INFINITY;
#pragma unroll
      for (int sub = 0; sub < 2; ++sub)
#pragma unroll
        for (int e = 0; e < 16; ++e) sc[sub][e] *= (0.125f * LOG2E);
      if (diag) {
        asm volatile("" ::: "memory");
#pragma unroll
        for (int sub = 0; sub < 2; ++sub)
#pragma unroll
          for (int e = 0; e < 16; ++e)
            if (kt * 64 + sub * 32 + (e & 3) + 8 * (e >> 2) + 4 * h > qpos) sc[sub][e] = -INFINITY;
      }
#pragma unroll
      for (int sub = 0; sub < 2; ++sub)
#pragma unroll
        for (int e = 0; e < 16; ++e) mx = fmaxf(mx, sc[sub][e]);
      mx = fmaxf(mx, __shfl_xor(mx, 32));
      const float mnew = fmaxf(mrun, mx);
      const bool resc = __builtin_amdgcn_ballot_w64(mnew != mrun) != 0ull;
      const float mold = mrun;
      mrun = mnew;
      float ls = 0.f;
      bf16x8 pf[2][2];
#pragma unroll
      for (int sub = 0; sub < 2; ++sub)
#pragma unroll
        for (int s2 = 0; s2 < 2; ++s2) {
          float pv[8];
#pragma unroll
          for (int j = 0; j < 8; ++j) { pv[j] = __builtin_amdgcn_exp2f(sc[sub][8 * s2 + j] - mnew); ls += pv[j]; }
          union { bf16x8 v; u32 w[4]; } cv;
          cv.w[0] = pk2(pv[0], pv[1]); cv.w[1] = pk2(pv[2], pv[3]); cv.w[2] = pk2(pv[4], pv[5]); cv.w[3] = pk2(pv[6], pv[7]);
          pf[sub][s2] = cv.v;
        }
      if (resc) {
        const float alpha = __builtin_amdgcn_exp2f(mold - mnew);
        lrun *= alpha;
#pragma unroll
        for (int d = 0; d < 2; ++d)
#pragma unroll
          for (int e = 0; e < 16; ++e) accO[d][e] *= alpha;
      }
      lrun += ls;
#pragma unroll
      for (int d = 0; d < 2; ++d) {
#pragma unroll
        for (int sub = 0; sub < 2; ++sub)
#pragma unroll
          for (int s2 = 0; s2 < 2; ++s2) {
            const u16* vp = Vt + (d * 32 + r) * AT_KROW + sub * 32 + 16 * s2 + 4 * h;
            union { bf16x8 v; uint2 w[2]; } av;
            av.w[0] = *(const uint2*)(vp);
            av.w[1] = *(const uint2*)(vp + 8);
            accO[d] = __builtin_amdgcn_mfma_f32_32x32x16_bf16(av.v, pf[sub][s2], accO[d], 0, 0, 0);
          }
      }
    }
    if (more) swrite((kt - 1) & 1);
    __syncthreads();
  }
  const float ltot = lrun + __shfl_xor(lrun, 32);
  const float inv = 1.f / ltot;
#pragma unroll
  for (int d = 0; d < 2; ++d)
#pragma unroll
    for (int e4 = 0; e4 < 4; ++e4) {
      const int dd = d * 32 + 8 * e4 + 4 * h;
      uint2 o;
      o.x = pk2(accO[d][e4 * 4 + 0] * inv, accO[d][e4 * 4 + 1] * inv);
      o.y = pk2(accO[d][e4 * 4 + 2] * inv, accO[d][e4 * 4 + 3] * inv);
      *(uint2*)(Yb + tokq * 512 + hh * 64 + dd) = o;
    }
}
__device__ __forceinline__ void ph_attn(const Params& p, int l, unsigned char* smem, int bid, int nb) {
  unsigned* qw = (unsigned*)(p.ws + WS_CTR) + 3600 + 64 * l;
  int* nxt = (int*)(smem + 2 * AT_STAGE + 16);
  for (;;) {
    if (opaque_tid() == 0) *nxt = (int)__hip_atomic_fetch_add(qw, 1u, __ATOMIC_RELAXED, __HIP_MEMORY_SCOPE_AGENT);
    __syncthreads();
    const int idx = *nxt;
    __syncthreads();
    if (idx >= 1024) break;
    if (idx < 512) attn_item(p, smem, 31 - (idx >> 4), idx & 15);
    else mixerA_item(p, l, smem, idx - 512);
  }
}

constexpr int PXW = 72, PXG = 136, PXV = 520, PXD = 40;
__device__ __forceinline__ void prep_item(const Params& p, int l, unsigned char* smem, int item) {
  const int tok0 = item * 32, tid = opaque_tid();
  const int lane = tid & 63, wave = tid >> 6, r = lane & 31, h = lane >> 5;
  u16* XW = (u16*)smem;
  u16* XA = XW + 32 * PXW;
  u16* XG = XA + 32 * PXW;
  u16* XV = XG + 32 * PXG;
  u16* XD = XV + 32 * PXV;
  float* VDP = (float*)(XD + 32 * PXD);
  const u16* pc = (const u16*)(p.ws + R_PC);
  const float* mu = p.in[I_C_MU] + l * 1792;
  const u16* Wb = (const u16*)(p.ws + R_W);
  u16* oR = (u16*)(p.ws + RW_R); u16* oW = (u16*)(p.ws + RW_W); u16* oK = (u16*)(p.ws + RW_K);
  u16* oV = (u16*)(p.ws + RW_V); u16* oA = (u16*)(p.ws + RW_A); u16* oG = (u16*)(p.ws + RW_G);
  u16* vf = (u16*)(p.ws + R_VF);
#pragma unroll 1
  for (int i2 = 0; i2 < 14; i2 += 2) {
    uint4 curv[2], prvv[2]; float4 muA[2], muB[2];
#pragma unroll
    for (int u = 0; u < 2; ++u) {
      const int cc = tid + 512 * (i2 + u), tt = cc / 224, c8 = (cc % 224) * 8;
      const int tok = tok0 + tt;
      curv[u] = *(const uint4*)(pc + (size_t)tok * 1792 + c8);
      prvv[u] = make_uint4(0, 0, 0, 0);
      if ((tok & (S - 1)) != 0) prvv[u] = *(const uint4*)(pc + (size_t)(tok - 1) * 1792 + c8);
      muA[u] = *(const float4*)(mu + c8); muB[u] = *(const float4*)(mu + c8 + 4);
    }
    __builtin_amdgcn_sched_barrier(0);
#pragma unroll
    for (int u = 0; u < 2; ++u) {
    const int cc = tid + 512 * (i2 + u), tt = cc / 224, c8 = (cc % 224) * 8;
    const int tok = tok0 + tt;
    const uint4 cur = curv[u], prv = prvv[u];
    const u32 cw[4] = {cur.x, cur.y, cur.z, cur.w}, pw[4] = {prv.x, prv.y, prv.z, prv.w};
    float xs[8];
    const float mv[8] = {muA[u].x, muA[u].y, muA[u].z, muA[u].w, muB[u].x, muB[u].y, muB[u].z, muB[u].w};
#pragma unroll
    for (int e = 0; e < 4; ++e) {
      const float c0 = bflo(cw[e]), c1 = bfhi(cw[e]);
      xs[2 * e] = c0 + (bflo(pw[e]) - c0) * mv[2 * e];
      xs[2 * e + 1] = c1 + (bfhi(pw[e]) - c1) * mv[2 * e + 1];
    }
    if (c8 >= 1536) {
      if (c8 < 1600) {
#pragma unroll
        for (int e = 0; e < 8; ++e) xs[e] = tanhf(xs[e]);
      } else if (c8 >= 1664) {
#pragma unroll
        for (int e = 0; e < 8; ++e) xs[e] = sigmoidf_(xs[e]);
      }
    }
    uint4 o; o.x = pk2(xs[0], xs[1]); o.y = pk2(xs[2], xs[3]); o.z = pk2(xs[4], xs[5]); o.w = pk2(xs[6], xs[7]);
    if (c8 < 512) *(uint4*)(oR + (size_t)tok * 512 + c8) = o;
    else if (c8 < 1024) *(uint4*)(oK + (size_t)tok * 512 + (c8 - 512)) = o;
    else if (c8 < 1536) {
      if (l == 0) { *(uint4*)(oV + (size_t)tok * 512 + (c8 - 1024)) = o; *(uint4*)(vf + (size_t)tok * 512 + (c8 - 1024)) = o; }
      else *(uint4*)(XV + tt * PXV + (c8 - 1024)) = o;
    } else if (c8 < 1600) *(uint4*)(XW + tt * PXW + (c8 - 1536)) = o;
    else if (c8 < 1664) *(uint4*)(XA + tt * PXW + (c8 - 1600)) = o;
    else *(uint4*)(XG + tt * PXG + (c8 - 1664)) = o;
  }
  }
  __syncthreads();
  const int c0 = wave * 64;
  f32x16 acc[2];
#define LR_GEMM(XP, PITCH, WOFF, KD)                                                                            \
  {                                                                                                             \
    bf16x8 bqs[(KD) / 16][2];                                                                                   \
    _Pragma("unroll") for (int ks = 0; ks < (KD) / 16; ++ks) _Pragma("unroll") for (int nt = 0; nt < 2; ++nt)   \
      bqs[ks][nt] = *(const bf16x8*)(Wb + (WOFF) + (size_t)(c0 + 32 * nt + r) * (KD) + ks * 16 + h * 8);        \
    __builtin_amdgcn_sched_barrier(0);                                                                          \
    _Pragma("unroll") for (int nt = 0; nt < 2; ++nt) _Pragma("unroll") for (int e = 0; e < 16; ++e) acc[nt][e] = 0.f; \
    _Pragma("unroll") for (int ks = 0; ks < (KD) / 16; ++ks) {                                                   \
      const bf16x8 a = *(const bf16x8*)((XP) + r * (PITCH) + ks * 16 + h * 8);                                    \
      _Pragma("unroll") for (int nt = 0; nt < 2; ++nt)                                                            \
        acc[nt] = __builtin_amdgcn_mfma_f32_32x32x16_bf16(a, bqs[ks][nt], acc[nt], 0, 0, 0);                      \
    }                                                                                                           \
  }
  LR_GEMM(XW, PXW, WO_WUP, 64)
#pragma unroll
  for (int nt = 0; nt < 2; ++nt) {
    const int c = c0 + 32 * nt + r;
    const float w0 = p.in[I_C_W0][l * 512 + c];
#pragma unroll
    for (int e = 0; e < 16; ++e) {
      const int t = (e & 3) + 8 * (e >> 2) + 4 * h;
      oW[(size_t)(tok0 + t) * 512 + c] = f2bf(-softplusf_(-(w0 + acc[nt][e])) - 0.5f);
    }
  }
  LR_GEMM(XA, PXW, WO_AUP, 64)
#pragma unroll
  for (int nt = 0; nt < 2; ++nt) {
    const int c = c0 + 32 * nt + r;
    const float a00 = p.in[I_C_A0][l * 512 + c];
#pragma unroll
    for (int e = 0; e < 16; ++e) {
      const int t = (e & 3) + 8 * (e >> 2) + 4 * h;
      oA[(size_t)(tok0 + t) * 512 + c] = f2bf(sigmoidf_(a00 + acc[nt][e]));
    }
  }
  LR_GEMM(XG, PXG, WO_GUP, 128)
#pragma unroll
  for (int nt = 0; nt < 2; ++nt) {
    const int c = c0 + 32 * nt + r;
#pragma unroll
    for (int e = 0; e < 16; ++e) {
      const int t = (e & 3) + 8 * (e >> 2) + 4 * h;
      oG[(size_t)(tok0 + t) * 512 + c] = f2bf(acc[nt][e]);
    }
  }
  if (l > 0) {
    {
      f32x16 pacc;
#pragma unroll
      for (int e = 0; e < 16; ++e) pacc[e] = 0.f;
#pragma unroll
      for (int ks = 0; ks < 4; ++ks) {
        const bf16x8 a = *(const bf16x8*)(XV + r * PXV + wave * 64 + ks * 16 + h * 8);
        const bf16x8 bq = *(const bf16x8*)(Wb + WO_VDN + (size_t)r * 512 + wave * 64 + ks * 16 + h * 8);
        pacc = __builtin_amdgcn_mfma_f32_32x32x16_bf16(a, bq, pacc, 0, 0, 0);
      }
#pragma unroll
      for (int e = 0; e < 16; ++e) VDP[(wave * 32 + (e & 3) + 8 * (e >> 2) + 4 * h) * 33 + r] = pacc[e];
    }
    __syncthreads();
#pragma unroll
    for (int q = 0; q < 2; ++q) {
      const int o = tid + 512 * q, t = o >> 5, m = o & 31;
      float sm = 0.f;
#pragma unroll
      for (int w8 = 0; w8 < 8; ++w8) sm += VDP[(w8 * 32 + t) * 33 + m];
      XD[t * PXD + m] = f2bf(sm);
    }
    __syncthreads();
#pragma unroll
    for (int nt = 0; nt < 2; ++nt)
#pragma unroll
      for (int e = 0; e < 16; ++e) acc[nt][e] = 0.f;
#pragma unroll
    for (int ks = 0; ks < 2; ++ks) {
      const bf16x8 a = *(const bf16x8*)(XD + r * PXD + ks * 16 + h * 8);
#pragma unroll
      for (int nt = 0; nt < 2; ++nt) {
        const bf16x8 bq = *(const bf16x8*)(Wb + WO_VUP + (size_t)(c0 + 32 * nt + r) * 64 + ks * 16 + h * 8);
        acc[nt] = __builtin_amdgcn_mfma_f32_32x32x16_bf16(a, bq, acc[nt], 0, 0, 0);
      }
    }
    float vfv[2][16];
#pragma unroll
    for (int nt = 0; nt < 2; ++nt)
#pragma unroll
      for (int e = 0; e < 16; ++e) vfv[nt][e] = bf2f(vf[(size_t)(tok0 + (e & 3) + 8 * (e >> 2) + 4 * h) * 512 + c0 + 32 * nt + r]);
    __builtin_amdgcn_sched_barrier(0);
#pragma unroll
    for (int nt = 0; nt < 2; ++nt) {
      const int c = c0 + 32 * nt + r;
      const float v0 = p.in[I_C_V0][(l - 1) * 512 + c];
#pragma unroll
      for (int e = 0; e < 16; ++e) {
        const int t = (e & 3) + 8 * (e >> 2) + 4 * h;
        const float gate = sigmoidf_(v0 + acc[nt][e]);
        const float v = bf2f(XV[t * PXV + c]);
        oV[(size_t)(tok0 + t) * 512 + c] = f2bf(v + (vfv[nt][e] - v) * gate);
      }
    }
  }
#undef LR_GEMM
  __syncthreads();
}
__device__ __forceinline__ void ph_prep(const Params& p, int l, unsigned char* smem, int bid, int nb) {
  for (int it = bid; it < T / 32; it += nb) prep_item(p, l, smem, it);
}

struct FragPtrs { unsigned char* fa; unsigned char* fb; unsigned char* fc; unsigned char* fd; };
__device__ __forceinline__ FragPtrs frag_ptrs(const Params& p, int l) {
  FragPtrs f;
  f.fa = p.ws + 9 * U;
  f.fb = (l == 0) ? (unsigned char*)p.out : p.ws + R_VF;
  f.fc = p.ws + R_W + WO_GU * 2;
  f.fd = p.ws + R_W + WO_IN * 2;
  return f;
}
constexpr int P2P = 72;
__device__ __forceinline__ void prep2_item(const Params& p, int l, const FragPtrs& fp, u16* sw, int rec, int lane) {
  const int bh = rec >> 8, c = rec & 255, b = bh >> 3, hh = bh & 7, cb = hh * 64;
  const int r = lane & 31, h = lane >> 5;
  const size_t tok0 = (size_t)b * S + c * 32;
  const u16* gR = (const u16*)(p.ws + RW_R); const u16* gW = (const u16*)(p.ws + RW_W);
  const u16* gK = (const u16*)(p.ws + RW_K); const u16* gA = (const u16*)(p.ws + RW_A);
  u16* sA = sw; u16* sR = sA + 32 * P2P; u16* sB = sR + 32 * P2P; u16* sK = sB + 32 * P2P;
  const float kkc = p.in[I_C_K_K][l * 512 + cb + lane], kac = p.in[I_C_K_A][l * 512 + cb + lane];
  float G = 0.f;
  {
    const u16* pR = gR + tok0 * 512 + cb + lane; const u16* pW = gW + tok0 * 512 + cb + lane;
    const u16* pK = gK + tok0 * 512 + cb + lane; const u16* pA = gA + tok0 * 512 + cb + lane;
#pragma unroll 1
    for (int t8 = 0; t8 < 32; t8 += 8) {
    u16 raw[8][4];
#pragma unroll
    for (int u = 0; u < 8; ++u) { raw[u][0] = pR[(t8 + u) * 512]; raw[u][1] = pW[(t8 + u) * 512]; raw[u][2] = pK[(t8 + u) * 512]; raw[u][3] = pA[(t8 + u) * 512]; }
    __builtin_amdgcn_sched_barrier(0);
#pragma unroll
    for (int u = 0; u < 8; ++u) {
      const int t = t8 + u;
      const float rv = bf2f(raw[u][0]), wv = bf2f(raw[u][1]), kv = bf2f(raw[u][2]), av = bf2f(raw[u][3]);
      const float ld = -__expf(wv);
      const float Gp = G;
      G += ld;
      const float kr = kv * kkc;
      const float n2 = wave_sum_fast(kr * kr);
      const float kk = kr * __builtin_amdgcn_rsqf(fmaxf(n2, 1e-24f));
      const float beta = kk * av, kp = kv * (1.f + (av - 1.f) * kac);
      const float eG = __expf(G), eGp = __expf(Gp), eGn = __expf(-G);
      sA[t * P2P + lane] = f2bf(-kk * eGp);
      sR[t * P2P + lane] = f2bf(rv * eG);
      sB[t * P2P + lane] = f2bf(beta * eGn);
      sK[t * P2P + lane] = f2bf(kp * eGn);
    }
    }
  }
  const float GL = __expf(G);
  *(float*)(fp.fd + (size_t)rec * 2304 + 2048 + lane * 4) = GL;
  const float GLx = __shfl_xor(GL, 32);
  __builtin_amdgcn_wave_barrier();
  __builtin_amdgcn_s_waitcnt(0xc07f);
  asm volatile("" ::: "memory");
#pragma unroll
  for (int jt = 0; jt < 2; ++jt) {
    const float gl = (jt == h) ? GL : GLx;
#pragma unroll
    for (int ks = 0; ks < 2; ++ks) {
      float vb[8], vk[8];
#pragma unroll
      for (int e = 0; e < 8; ++e) {
        const int t = 16 * ks + 8 * (e >> 2) + 4 * h + (e & 3);
        vb[e] = bf2f(sB[t * P2P + 32 * jt + r]) * gl;
        vk[e] = bf2f(sK[t * P2P + 32 * jt + r]) * gl;
      }
      *(uint4*)(fp.fa + (size_t)rec * 14336 + (8 + jt * 2 + ks) * 1024 + lane * 16) = make_uint4(pk2(vb[0], vb[1]), pk2(vb[2], vb[3]), pk2(vb[4], vb[5]), pk2(vb[6], vb[7]));
      *(uint4*)(fp.fb + (size_t)rec * 4096 + (jt * 2 + ks) * 1024 + lane * 16) = make_uint4(pk2(vk[0], vk[1]), pk2(vk[2], vk[3]), pk2(vk[4], vk[5]), pk2(vk[6], vk[7]));
    }
  }
#pragma unroll
  for (int ks = 0; ks < 4; ++ks) {
    const uint2 a0 = *(const uint2*)(sA + r * P2P + 16 * ks + 4 * h), a1 = *(const uint2*)(sA + r * P2P + 16 * ks + 8 + 4 * h);
    const uint2 r0 = *(const uint2*)(sR + r * P2P + 16 * ks + 4 * h), r1 = *(const uint2*)(sR + r * P2P + 16 * ks + 8 + 4 * h);
    *(uint4*)(fp.fa + (size_t)rec * 14336 + ks * 1024 + lane * 16) = make_uint4(a0.x, a0.y, a1.x, a1.y);
    *(uint4*)(fp.fa + (size_t)rec * 14336 + (4 + ks) * 1024 + lane * 16) = make_uint4(r0.x, r0.y, r1.x, r1.y);
  }
  f32x16 Dab, Dak, Drb, Drk;
#pragma unroll
  for (int e = 0; e < 16; ++e) { Dab[e] = 0.f; Dak[e] = 0.f; Drb[e] = 0.f; Drk[e] = 0.f; }
#pragma unroll
  for (int ks = 0; ks < 4; ++ks) {
    const bf16x8 fb = *(const bf16x8*)(sB + r * P2P + ks * 16 + h * 8);
    const bf16x8 fk = *(const bf16x8*)(sK + r * P2P + ks * 16 + h * 8);
    const bf16x8 fa = *(const bf16x8*)(sA + r * P2P + ks * 16 + h * 8);
    const bf16x8 fr = *(const bf16x8*)(sR + r * P2P + ks * 16 + h * 8);
    Dab = __builtin_amdgcn_mfma_f32_32x32x16_bf16(fb, fa, Dab, 0, 0, 0);
    Dak = __builtin_amdgcn_mfma_f32_32x32x16_bf16(fk, fa, Dak, 0, 0, 0);
    Drb = __builtin_amdgcn_mfma_f32_32x32x16_bf16(fb, fr, Drb, 0, 0, 0);
    Drk = __builtin_amdgcn_mfma_f32_32x32x16_bf16(fk, fr, Drk, 0, 0, 0);
  }
#pragma unroll
  for (int e = 0; e < 16; ++e) {
    const int sI = (e & 3) + 8 * (e >> 2) + 4 * h;
    if (!(sI < r)) { Dab[e] = 0.f; Dak[e] = 0.f; }
    if (!(sI <= r)) { Drb[e] = 0.f; Drk[e] = 0.f; }
  }
#pragma unroll
  for (int ks = 0; ks < 2; ++ks) {
    uint4 w;
    w.x = pk2(Dak[8 * ks + 0], Dak[8 * ks + 1]); w.y = pk2(Dak[8 * ks + 2], Dak[8 * ks + 3]); w.z = pk2(Dak[8 * ks + 4], Dak[8 * ks + 5]); w.w = pk2(Dak[8 * ks + 6], Dak[8 * ks + 7]);
    *(uint4*)(fp.fc + (size_t)rec * 4096 + ks * 1024 + lane * 16) = w;
    w.x = pk2(Drb[8 * ks + 0], Drb[8 * ks + 1]); w.y = pk2(Drb[8 * ks + 2], Drb[8 * ks + 3]); w.z = pk2(Drb[8 * ks + 4], Drb[8 * ks + 5]); w.w = pk2(Drb[8 * ks + 6], Drb[8 * ks + 7]);
    *(uint4*)(fp.fc + (size_t)rec * 4096 + (2 + ks) * 1024 + lane * 16) = w;
    w.x = pk2(Drk[8 * ks + 0], Drk[8 * ks + 1]); w.y = pk2(Drk[8 * ks + 2], Drk[8 * ks + 3]); w.z = pk2(Drk[8 * ks + 4], Drk[8 * ks + 5]); w.w = pk2(Drk[8 * ks + 6], Drk[8 * ks + 7]);
    *(uint4*)(fp.fd + (size_t)rec * 2304 + ks * 1024 + lane * 16) = w;
  }
  __builtin_amdgcn_wave_barrier();
  __builtin_amdgcn_s_waitcnt(0xc07f);
  asm volatile("" ::: "memory");
  float* LT = (float*)sB;
#pragma unroll
  for (int q = 0; q < 4; ++q) *(float4*)(LT + r * 36 + 8 * q + 4 * h) = make_float4(Dab[4 * q], Dab[4 * q + 1], Dab[4 * q + 2], Dab[4 * q + 3]);
  __builtin_amdgcn_wave_barrier();
  __builtin_amdgcn_s_waitcnt(0xc07f);
  asm volatile("" ::: "memory");
  float x[32];
#pragma unroll
  for (int m = 0; m < 32; ++m) x[m] = 0.f;
#pragma unroll
  for (int sI = 31; sI >= 1; --sI) {
    const float xs = x[sI] + ((sI == r) ? 1.f : 0.f);
    x[sI] = xs;
#pragma unroll
    for (int m4 = 0; m4 < sI; m4 += 4) {
      const float4 v = *(const float4*)(LT + sI * 36 + m4);
      x[m4] += v.x * xs; x[m4 + 1] += v.y * xs; x[m4 + 2] += v.z * xs; x[m4 + 3] += v.w * xs;
    }
  }
  x[0] += (r == 0) ? 1.f : 0.f;
#pragma unroll
  for (int ks = 0; ks < 2; ++ks) {
    uint4 w;
    w.x = h ? pk2(x[16 * ks + 4], x[16 * ks + 5]) : pk2(x[16 * ks + 0], x[16 * ks + 1]);
    w.y = h ? pk2(x[16 * ks + 6], x[16 * ks + 7]) : pk2(x[16 * ks + 2], x[16 * ks + 3]);
    w.z = h ? pk2(x[16 * ks + 12], x[16 * ks + 13]) : pk2(x[16 * ks + 8], x[16 * ks + 9]);
    w.w = h ? pk2(x[16 * ks + 14], x[16 * ks + 15]) : pk2(x[16 * ks + 10], x[16 * ks + 11]);
    *(uint4*)(fp.fa + (size_t)rec * 14336 + (12 + ks) * 1024 + lane * 16) = w;
  }
  __builtin_amdgcn_wave_barrier();
  __builtin_amdgcn_s_waitcnt(0xc07f);
  asm volatile("" ::: "memory");
}
__device__ __forceinline__ void ph_prep2(const Params& p, int l, unsigned char* smem, int bid, int nb) {
  const int lane = opaque_tid() & 63, wave = opaque_tid() >> 6;
  const FragPtrs fp = frag_ptrs(p, l);
  u16* sw = (u16*)(smem + wave * (4 * 32 * P2P * 2));
  for (int rec = bid * 8 + wave; rec < 4096; rec += nb * 8) prep2_item(p, l, fp, sw, rec, lane);
}

__device__ __forceinline__ bf16x8 pack8(const f32x16& a, int s2) {
  union { bf16x8 v; u32 w[4]; } cv;
  cv.w[0] = pk2(a[8 * s2 + 0], a[8 * s2 + 1]); cv.w[1] = pk2(a[8 * s2 + 2], a[8 * s2 + 3]);
  cv.w[2] = pk2(a[8 * s2 + 4], a[8 * s2 + 5]); cv.w[3] = pk2(a[8 * s2 + 6], a[8 * s2 + 7]);
  return cv.v;
}
constexpr int SC_SLOT = 24 * 1024 + 256 + 4096, SC_NS = 5;
__device__ __forceinline__ void ph_scan2(const Params& p, int l, unsigned char* smem, int bid, int nb) {
  const int lane = opaque_tid() & 63, wave = __builtin_amdgcn_readfirstlane(opaque_tid() >> 6), r = lane & 31, h = lane >> 5;
  const FragPtrs fp = frag_ptrs(p, l);
  const u16* gV = (const u16*)(p.ws + RW_V);
  u16* gY = (u16*)(p.ws + R_YC);
  for (int bh = bid; bh < 16; bh += nb) {
    const size_t rec0 = (size_t)bh * 256;
    if (wave >= 2) {
      const int lw = wave - 2;
      const size_t tbL = (size_t)(bh >> 3) * S; const int cbL = (bh & 7) * 64;
#define SC_ISSUE(C)                                                                                                              \
      {                                                                                                                          \
        const int cc_ = (C) < 256 ? (C) : 255;                                                                                   \
        unsigned char* slot_ = smem + ((C) % SC_NS) * SC_SLOT;                                                                   \
        const size_t rec_ = rec0 + cc_;                                                                                          \
        _Pragma("unroll") for (int q = 0; q < 4; ++q) {                                                                          \
          const int f = lw * 4 + q;                                                                                              \
          const unsigned char* src_ = f < 14 ? fp.fa + rec_ * 14336 + f * 1024                                                   \
                                    : (f < 18 ? fp.fb + rec_ * 4096 + (f - 14) * 1024                                            \
                                    : (f < 22 ? fp.fc + rec_ * 4096 + (f - 18) * 1024 : fp.fd + rec_ * 2304 + (f - 22) * 1024)); \
          __builtin_amdgcn_global_load_lds((const unsigned*)(src_ + lane * 16), (unsigned*)(slot_ + f * 1024), 16, 0, 0);         \
        }                                                                                                                        \
        if (lw == 5) __builtin_amdgcn_global_load_lds((const unsigned*)(fp.fd + rec_ * 2304 + 2048 + lane * 4), (unsigned*)(slot_ + 24576), 4, 0, 0); \
        if (lw < 4) __builtin_amdgcn_global_load_lds((const unsigned*)(gV + (tbL + cc_ * 32 + lw * 8 + (lane >> 3)) * 512 + cbL + (lane & 7) * 8), (unsigned*)(slot_ + 24832 + lw * 1024), 16, 0, 0); \
      }
      SC_ISSUE(0) SC_ISSUE(1) SC_ISSUE(2) SC_ISSUE(3)
      if (lw == 4) asm volatile("s_waitcnt vmcnt(12)" ::: "memory"); else asm volatile("s_waitcnt vmcnt(15)" ::: "memory");
      __builtin_amdgcn_s_barrier();
#pragma unroll 1
      for (int c = 0; c < 256; ++c) {
        SC_ISSUE(c + 4)
        if (lw == 4) asm volatile("s_waitcnt vmcnt(12)" ::: "memory"); else asm volatile("s_waitcnt vmcnt(15)" ::: "memory");
        __builtin_amdgcn_s_barrier();
      }
      asm volatile("s_waitcnt vmcnt(0)" ::: "memory");
#undef SC_ISSUE
    } else {
      const int it = wave;
      const int b = bh >> 3, hh = bh & 7, cb = hh * 64;
      const size_t tb = (size_t)b * S;
      const int voff = (4 * h) * 512 + r;
      f32x16 ST[2];
#pragma unroll
      for (int jt = 0; jt < 2; ++jt)
#pragma unroll
        for (int e = 0; e < 16; ++e) ST[jt][e] = 0.f;
      asm volatile("s_waitcnt lgkmcnt(0)" ::: "memory");
      __builtin_amdgcn_s_barrier();
#pragma unroll 1
      for (int c = 0; c < 256; ++c) {
        const unsigned char* slot = smem + (c % SC_NS) * SC_SLOT;
#define FR_(f) (*(const bf16x8*)(slot + (f) * 1024 + lane * 16))
        bf16x8 fA[10];
#pragma unroll
        for (int ks = 0; ks < 4; ++ks) { fA[ks] = FR_(ks); fA[6 + ks] = FR_(4 + ks); }
#pragma unroll
        for (int ks = 0; ks < 2; ++ks) fA[4 + ks] = FR_(18 + ks);
        float4 gm[2][4];
#pragma unroll
        for (int jt = 0; jt < 2; ++jt)
#pragma unroll
          for (int q = 0; q < 4; ++q) gm[jt][q] = *(const float4*)(slot + 24576 + (32 * jt + 8 * q + 4 * h) * 4);
        __builtin_amdgcn_sched_barrier(0);
        bf16x8 fB[14];
#pragma unroll
        for (int ks = 0; ks < 2; ++ks) fB[ks] = FR_(12 + ks);
#pragma unroll
        for (int q = 0; q < 4; ++q) { fB[2 + q] = FR_(8 + q); fB[6 + q] = FR_(14 + q); }
        bf16x8 Vf[2];
        {
          const u16* vt = (const u16*)(slot + 24832) + 32 * it + r;
#pragma unroll
          for (int ks = 0; ks < 2; ++ks) {
            union { bf16x8 v; u16 e[8]; } cv;
#pragma unroll
            for (int e = 0; e < 8; ++e) cv.e[e] = vt[(16 * ks + 8 * (e >> 2) + 4 * h + (e & 3)) * 64];
            Vf[ks] = cv.v;
          }
        }
        __builtin_amdgcn_sched_barrier(0);
        bf16x8 stb[4];
#pragma unroll
        for (int ks = 0; ks < 4; ++ks) stb[ks] = pack8(ST[ks >> 1], ks & 1);
        f32x16 N[2];
#pragma unroll
        for (int jt = 0; jt < 2; ++jt)
#pragma unroll
          for (int q = 0; q < 4; ++q) {
            N[jt][4 * q + 0] = ST[jt][4 * q + 0] * gm[jt][q].x; N[jt][4 * q + 1] = ST[jt][4 * q + 1] * gm[jt][q].y;
            N[jt][4 * q + 2] = ST[jt][4 * q + 2] * gm[jt][q].z; N[jt][4 * q + 3] = ST[jt][4 * q + 3] * gm[jt][q].w;
          }
        f32x16 X1;
#pragma unroll
        for (int e = 0; e < 16; ++e) X1[e] = 0.f;
#pragma unroll
        for (int ks = 0; ks < 4; ++ks) X1 = __builtin_amdgcn_mfma_f32_32x32x16_bf16(fA[ks], stb[ks], X1, 0, 0, 0);
#pragma unroll
        for (int ks = 0; ks < 2; ++ks) X1 = __builtin_amdgcn_mfma_f32_32x32x16_bf16(fA[4 + ks], Vf[ks], X1, 0, 0, 0);
        f32x16 Y;
#pragma unroll
        for (int e = 0; e < 16; ++e) Y[e] = 0.f;
#pragma unroll
        for (int ks = 0; ks < 4; ++ks) Y = __builtin_amdgcn_mfma_f32_32x32x16_bf16(fA[6 + ks], stb[ks], Y, 0, 0, 0);
        f32x16 Ut;
#pragma unroll
        for (int e = 0; e < 16; ++e) Ut[e] = 0.f;
#pragma unroll
        for (int ks = 0; ks < 2; ++ks) Ut = __builtin_amdgcn_mfma_f32_32x32x16_bf16(fB[ks], pack8(X1, ks), Ut, 0, 0, 0);
        __builtin_amdgcn_sched_barrier(0);
#pragma unroll
        for (int ks = 0; ks < 2; ++ks) { fB[10 + ks] = FR_(20 + ks); fB[12 + ks] = FR_(22 + ks); }
        __builtin_amdgcn_sched_barrier(0);
        bf16x8 utb[2];
#pragma unroll
        for (int ks = 0; ks < 2; ++ks) utb[ks] = pack8(Ut, ks);
#pragma unroll
        for (int jt = 0; jt < 2; ++jt) {
#pragma unroll
          for (int ks = 0; ks < 2; ++ks) N[jt] = __builtin_amdgcn_mfma_f32_32x32x16_bf16(fB[2 + jt * 2 + ks], utb[ks], N[jt], 0, 0, 0);
#pragma unroll
          for (int ks = 0; ks < 2; ++ks) N[jt] = __builtin_amdgcn_mfma_f32_32x32x16_bf16(fB[6 + jt * 2 + ks], Vf[ks], N[jt], 0, 0, 0);
        }
#pragma unroll
        for (int ks = 0; ks < 2; ++ks) Y = __builtin_amdgcn_mfma_f32_32x32x16_bf16(fB[10 + ks], utb[ks], Y, 0, 0, 0);
#pragma unroll
        for (int ks = 0; ks < 2; ++ks) Y = __builtin_amdgcn_mfma_f32_32x32x16_bf16(fB[12 + ks], Vf[ks], Y, 0, 0, 0);
        ST[0] = N[0]; ST[1] = N[1];
#pragma unroll
        for (int e = 0; e < 16; ++e) {
          u16* yb_ = gY + (tb + c * 32 + 8 * (e >> 2)) * 512 + cb + 32 * it;
          yb_[voff + (e & 3) * 512] = f2bf(Y[e]);
        }
        asm volatile("s_waitcnt lgkmcnt(0)" ::: "memory");
        __builtin_amdgcn_s_barrier();
#undef FR_
      }
    }
  }
}

__device__ __forceinline__ void ph_post(const Params& p, int l, const float* xin, int bid, int nb) {
  const int lane = opaque_tid() & 63, wave = opaque_tid() >> 6;
  ph_rmsnorm(xin, p.in[I_NORM_MIX] + l * 1024, (u16*)(p.ws + R_H2), nullptr, bid * 8 + wave, nb * 8);
  const u16* gR = (const u16*)(p.ws + RW_R); const u16* gK = (const u16*)(p.ws + RW_K);
  const u16* gV = (const u16*)(p.ws + RW_V); const u16* gA = (const u16*)(p.ws + RW_A); const u16* gG = (const u16*)(p.ws + RW_G);
  u16* gY = (u16*)(p.ws + R_YC);
  const int gw = bid * 8 + wave, hh = gw & 7, c = hh * 64 + lane;
  const float cka = p.in[I_C_K_A][l * 512 + c], crk = p.in[I_C_R_K][l * 512 + c];
  const float clg = p.in[I_C_LNX_G][l * 512 + c], clb = p.in[I_C_LNX_B][l * 512 + c];
  const int ngw = nb * 8;
  for (int it0 = gw; it0 < T * 8; it0 += 4 * ngw) {
    float y[4], rv[4], kv[4], vv[4], av[4], gv[4];
    u16 raw[4][6];
#pragma unroll
    for (int u = 0; u < 4; ++u) {
      const int it = it0 + u * ngw;
      const size_t idx = (size_t)((it < T * 8 ? it : gw) >> 3) * 512 + c;
      raw[u][0] = gY[idx]; raw[u][1] = gR[idx]; raw[u][2] = gK[idx]; raw[u][3] = gV[idx]; raw[u][4] = gA[idx]; raw[u][5] = gG[idx];
    }
    __builtin_amdgcn_sched_barrier(0);
#pragma unroll
    for (int u = 0; u < 4; ++u) {
      y[u] = bf2f(raw[u][0]); rv[u] = bf2f(raw[u][1]); kv[u] = bf2f(raw[u][2]); vv[u] = bf2f(raw[u][3]); av[u] = bf2f(raw[u][4]); gv[u] = bf2f(raw[u][5]);
    }
#pragma unroll
    for (int u = 0; u < 4; ++u) {
      const int it = it0 + u * ngw;
      const float mu = wave_sum_fast(y[u]) * (1.f / 64.f);
      const float dv = y[u] - mu;
      const float var = wave_sum_fast(dv * dv) * (1.f / 64.f);
      const float kp = kv[u] * (1.f + (av[u] - 1.f) * cka);
      const float bonus = wave_sum_fast(rv[u] * kp * crk);
      float o = dv * rsqrtf(var + 64e-5f) * clg + clb;
      o = (o + bonus * vv[u]) * gv[u];
      if (it < T * 8) gY[(size_t)(it >> 3) * 512 + c] = f2bf(o);
    }
  }
}

__device__ __forceinline__ void ph_merge(const Params& p, int l, unsigned char* smem, int bid, int nb) {
  const u16* H2 = (const u16*)(p.ws + R_H2);
  const u16* Wb = (const u16*)(p.ws + R_W);
  u16* Mg = (u16*)(p.ws + R_MERGED);
  const int lane = opaque_tid() & 63, wave = opaque_tid() >> 6, wm = wave >> 1, wn = wave & 1, r = lane & 31, h = lane >> 5;
  bool pf = false;
  for (int t = bid; t < 64 * 8; t += nb) {
    int mt, nt; tile_decode(t, 8, mt, nt);
    const int m0 = mt * 256, n0 = nt * 128;
    f32x16 out[2][2]; acc_zero(out);
#pragma unroll 1
    for (int br = 0; br < 3; ++br) {
      f32x16 acc[2][2]; acc_zero(acc);
      gemm_kloop(H2 + (size_t)m0 * 1024, 1024, Wb + WO_IN + (size_t)(NMIX + br * 1024 + n0) * 1024, 1024, 1024, acc, (u16*)smem, pf, false);
      const u16* Y; const u16* P; int K;
      if (br == 0) { Y = (const u16*)(p.ws + R_UA) + (size_t)m0 * 1024; P = Wb + WO_PA + (size_t)n0 * 1024; K = 1024; }
      else if (br == 1) { Y = (const u16*)(p.ws + R_YB) + (size_t)m0 * 512; P = Wb + WO_PB + (size_t)n0 * 512; K = 512; }
      else { Y = (const u16*)(p.ws + R_YC) + (size_t)m0 * 512; P = Wb + WO_PC + (size_t)n0 * 512; K = 512; }
      gemm_prefetch(Y, K, P, K, K, (u16*)smem);
      const float* gb = p.in[I_GATE_BIAS] + (size_t)(l * 3 + br) * 1024 + n0 + wn * 64 + r;
      u32 gpk[2][2][8];
#pragma unroll
      for (int i = 0; i < 2; ++i)
#pragma unroll
        for (int j = 0; j < 2; ++j) {
          const float bj = gb[j * 32];
#pragma unroll
          for (int e = 0; e < 8; ++e) gpk[i][j][e] = pk2(sigmoidf_(acc[i][j][2 * e] + bj), sigmoidf_(acc[i][j][2 * e + 1] + bj));
        }
      acc_zero(acc);
      gemm_kloop(Y, K, P, K, K, acc, (u16*)smem, true, false);
      pf = true;
      if (br < 2) {
        gemm_prefetch(H2 + (size_t)m0 * 1024, 1024, Wb + WO_IN + (size_t)(NMIX + (br + 1) * 1024 + n0) * 1024, 1024, 1024, (u16*)smem);
      } else if (t + nb < 64 * 8) {
        int mt2, nt2; tile_decode(t + nb, 8, mt2, nt2);
        gemm_prefetch(H2 + (size_t)mt2 * 256 * 1024, 1024, Wb + WO_IN + (size_t)(NMIX + nt2 * 128) * 1024, 1024, 1024, (u16*)smem);
      } else pf = false;
#pragma unroll
      for (int i = 0; i < 2; ++i)
#pragma unroll
        for (int j = 0; j < 2; ++j)
#pragma unroll
          for (int e = 0; e < 8; ++e) {
            out[i][j][2 * e] += bflo(gpk[i][j][e]) * acc[i][j][2 * e];
            out[i][j][2 * e + 1] += bfhi(gpk[i][j][e]) * acc[i][j][2 * e + 1];
          }
    }
    EPI_LOOP(i, j, e) {
      const int m = m0 + wm * 64 + i * 32 + (e & 3) + 8 * (e >> 2) + 4 * h;
      Mg[(size_t)m * 1024 + n0 + wn * 64 + j * 32 + r] = f2bf(out[i][j][e]);
    }
  }
}

__device__ __forceinline__ void ph_resgemm(const u16* A, int K, const u16* Wt, const float* xin, float* xr, unsigned char* smem, int bid, int nb) {
  const int lane = opaque_tid() & 63, wave = opaque_tid() >> 6, wm = wave >> 1, wn = wave & 1, r = lane & 31, h = lane >> 5;
  bool pf = false;
  for (int t = bid; t < 64 * 8; t += nb) {
    int mt, nt; tile_decode(t, 8, mt, nt);
    const int m0 = mt * 256, n0 = nt * 128;
    f32x16 acc[2][2]; acc_zero(acc);
    gemm_kloop(A + (size_t)m0 * K, K, Wt + (size_t)n0 * K, K, K, acc, (u16*)smem, pf);
    pf = (t + nb < 64 * 8);
    if (pf) { int mt2, nt2; tile_decode(t + nb, 8, mt2, nt2); gemm_prefetch(A + (size_t)mt2 * 256 * K, K, Wt + (size_t)nt2 * 128 * K, K, K, (u16*)smem); }
#pragma unroll
    for (int i = 0; i < 2; ++i) {
      float tv[2][16];
#pragma unroll
      for (int j = 0; j < 2; ++j)
#pragma unroll
        for (int e = 0; e < 16; ++e) {
          const int m = m0 + wm * 64 + i * 32 + (e & 3) + 8 * (e >> 2) + 4 * h;
          tv[j][e] = xin[(size_t)m * 1024 + n0 + wn * 64 + j * 32 + r];
        }
      __builtin_amdgcn_sched_barrier(0);
#pragma unroll
      for (int j = 0; j < 2; ++j)
#pragma unroll
        for (int e = 0; e < 16; ++e) {
          const int m = m0 + wm * 64 + i * 32 + (e & 3) + 8 * (e >> 2) + 4 * h;
          xr[(size_t)m * 1024 + n0 + wn * 64 + j * 32 + r] = acc[i][j][e] + tv[j][e];
        }
      __builtin_amdgcn_sched_barrier(0);
    }
  }
}

__device__ __forceinline__ void ph_ffnup(const Params& p, unsigned char* smem, int bid, int nb) {
  const u16* Hf = (const u16*)(p.ws + R_HF);
  const u16* Wt = (const u16*)(p.ws + R_W) + WO_GU;
  u16* act = (u16*)(p.ws + R_ACT);
  const int lane = opaque_tid() & 63, wave = opaque_tid() >> 6, wm = wave >> 1, wn = wave & 1, r = lane & 31, h = lane >> 5;
  constexpr int NT = 5632 / 128;
  bool pf = false;
  for (int t = bid; t < 64 * NT; t += nb) {
    int mt, nt; tile_decode(t, NT, mt, nt);
    const int m0 = mt * 256, n0 = nt * 128;
    f32x16 acc[2][2]; acc_zero(acc);
    gemm_kloop(Hf + (size_t)m0 * 1024, 1024, Wt + (size_t)n0 * 1024, 1024, 1024, acc, (u16*)smem, pf);
    pf = (t + nb < 64 * NT);
    if (pf) { int mt2, nt2; tile_decode(t + nb, NT, mt2, nt2); gemm_prefetch(Hf + (size_t)mt2 * 256 * 1024, 1024, Wt + (size_t)nt2 * 128 * 1024, 1024, 1024, (u16*)smem); }
    const int col = ((n0 + wn * 64) >> 6) * 32 + r;
#pragma unroll
    for (int i = 0; i < 2; ++i)
#pragma unroll
      for (int e = 0; e < 16; ++e) {
        const int m = m0 + wm * 64 + i * 32 + (e & 3) + 8 * (e >> 2) + 4 * h;
        const float gt = acc[i][0][e], up = acc[i][1][e];
        act[(size_t)m * DFF + col] = f2bf(gt * sigmoidf_(gt) * up);
      }
  }
}

#define XB_XCNT(j)  (256  + 64 * (j))
#define XB_XSUB(j)  (1280 + 64 * (j))
#define XB_XGEN(j)  (2304 + 64 * (j))
#define XB_TOP      3328
#define XB_TOPGEN   3392
#define XCD_BAR_WORDS 3456
__device__ __forceinline__ unsigned xb_ld(unsigned* q) { return __hip_atomic_load(q, __ATOMIC_RELAXED, __HIP_MEMORY_SCOPE_AGENT); }
__device__ __forceinline__ unsigned xb_add(unsigned* q, unsigned v) { return __hip_atomic_fetch_add(q, v, __ATOMIC_RELAXED, __HIP_MEMORY_SCOPE_AGENT); }
__device__ __forceinline__ unsigned xb_xcc_id() { return (unsigned)__builtin_amdgcn_s_getreg((3 << 11) | 20) & 0xFu; }
__device__ __forceinline__ void xcd_grid_barrier(unsigned* bar, volatile unsigned* st, unsigned xcc, unsigned G) {
  asm volatile("s_waitcnt vmcnt(0)" ::: "memory");
  __syncthreads();
  if (opaque_tid() == 0) {
    __builtin_amdgcn_s_waitcnt(0);
    unsigned nloc = st[0], nx = st[1];
    if (nloc == 0u) {
      for (;;) {
        unsigned sum = 0u, cnt = 0u, mine = 0u;
#pragma unroll
        for (unsigned j = 0; j < 16; ++j) { const unsigned c = xb_ld(&bar[XB_XCNT(j)]); sum += c; cnt += (c > 0u) ? 1u : 0u; mine = (j == xcc) ? c : mine; }
        if (sum == G) { nloc = mine; nx = cnt; break; }
        __builtin_amdgcn_s_sleep(1);
      }
      st[0] = nloc; st[1] = nx;
    }
    const unsigned old = xb_add(&bar[XB_XSUB(xcc)], 1u);
    const unsigned gen = old / nloc;
    if (old + 1u == (gen + 1u) * nloc) {
      __builtin_amdgcn_fence(__ATOMIC_RELEASE, "agent");
      asm volatile("s_waitcnt vmcnt(0)" ::: "memory");
      const unsigned og = xb_add(&bar[XB_TOP], 1u);
      const unsigned tg = og / nx;
      if (og + 1u == (tg + 1u) * nx) xb_add(&bar[XB_TOPGEN], 1u);
      else while (xb_ld(&bar[XB_TOPGEN]) == tg) __builtin_amdgcn_s_sleep(1);
      __builtin_amdgcn_fence(__ATOMIC_ACQUIRE, "agent");
      xb_add(&bar[XB_XGEN(xcc)], 1u);
      asm volatile("s_waitcnt vmcnt(0)" ::: "memory");
    } else {
      while (xb_ld(&bar[XB_XGEN(xcc)]) == gen) __builtin_amdgcn_s_sleep(1);
      __builtin_amdgcn_fence(__ATOMIC_ACQUIRE, "agent");
      asm volatile("s_waitcnt vmcnt(0)" ::: "memory");
    }
  }
  __syncthreads();
}
#ifndef ONLY
#define ONLY -1
#endif
#define PH_ON(q) (ONLY < 0 || ONLY == (q))
constexpr int PH_PER_LAYER = 13;
constexpr int N_PHASES = 2 * PH_PER_LAYER + 1;

__global__ void __launch_bounds__(NTHR) fwd_kernel(Params p) {
  extern __shared__ __attribute__((aligned(16))) unsigned char smem[];
  const int bid = blockIdx.x, nb = gridDim.x;
  __shared__ unsigned xb_st[4];
  unsigned* xbar = (unsigned*)(p.ws + WS_CTR);
  const unsigned xcc = xb_xcc_id();
  if (opaque_tid() == 0) { xb_st[0] = 0u; xb_st[1] = 0u; (void)xb_add(&xbar[XB_XCNT(xcc)], 1u); }
  __syncthreads();
  for (int pi = 0; pi < p.nph; ++pi) {
    if (pi == 1) { cg::this_grid().sync(); }
    else if (pi > 1) { xcd_grid_barrier(xbar, xb_st, xcc, (unsigned)nb); }
    const int wave = opaque_tid() >> 6;
    const unsigned long long cw = pi < 12 ? p.code[0] : (pi < 24 ? p.code[1] : (pi < 36 ? p.code[2] : p.code[3]));
    const int pc_ = (int)((cw >> (5 * (pi % 12))) & 31);
    if (pc_ == 27) continue;
    if (pc_ == 26) {
      ph_rmsnorm(p.out, p.in[I_NORM_FINAL], nullptr, p.out, bid * 8 + wave, nb * 8);
      continue;
    }
    const int l = pc_ / PH_PER_LAYER, q = pc_ % PH_PER_LAYER;
    const float* xin = (l == 0) ? p.in[I_X] : p.out;
    switch (q) {
      case 0:
        if (PH_ON(0)) {
          ph_convert(p, l, smem, bid, nb, 0);
          ph_rmsnorm(xin, p.in[I_NORM_MIX] + l * 1024, (u16*)(p.ws + R_H), nullptr, bid * 8 + wave, nb * 8);
        }
        break;
      case 1: if (PH_ON(1)) { ph_inproj(p, l, smem, bid, nb); } break;
      case 2: if (PH_ON(2)) { ph_mixerA(p, l, smem, bid, nb); } break;
      case 3: if (PH_ON(3)) { ph_attn(p, l, smem, bid, nb); } break;
      case 4: if (PH_ON(4)) { ph_prep(p, l, smem, bid, nb); } break;
      case 5: if (PH_ON(5)) { ph_prep2(p, l, smem, bid, nb); } break;
      case 6: if (PH_ON(6)) { ph_scan2(p, l, smem, bid, nb); } break;
      case 7: if (PH_ON(7)) { ph_post(p, l, xin, bid, nb); } break;
      case 8: if (PH_ON(8)) { ph_merge(p, l, smem, bid, nb); } break;
      case 9: if (PH_ON(9)) { ph_resgemm((const u16*)(p.ws + R_MERGED), 1024, (const u16*)(p.ws + R_W) + WO_OUT, xin, p.out, smem, bid, nb); } break;
      case 10:
        if (PH_ON(10)) {
          ph_convert(p, l, smem, bid, nb, 1);
          ph_rmsnorm(p.out, p.in[I_NORM_FFN] + l * 1024, (u16*)(p.ws + R_HF), nullptr, bid * 8 + wave, nb * 8);
        }
        break;
      case 11: if (PH_ON(11)) { ph_ffnup(p, smem, bid, nb); } break;
      case 12: if (PH_ON(12)) { ph_resgemm((const u16*)(p.ws + R_ACT), DFF, (const u16*)(p.ws + R_W) + WO_DN, p.out, p.out, smem, bid, nb); } break;
    }
  }
}

extern "C" void kernel_launch(void* const* d_in, const int* in_sizes, int n_in, void* d_out, int out_size, void* d_ws, size_t ws_size,
                              hipStream_t stream) {
  static int grid = 0;
  if (grid == 0) {
    if (n_in != 31 || ws_size < WS_END) { fprintf(stderr, "kernel_launch: unexpected n_in %d / ws_size %zu (need %zu)\n", n_in, ws_size, (size_t)WS_END); grid = -1; return; }
    int dev = 0, cus = 0, per_cu = 0;
    hipGetDevice(&dev);
    hipDeviceGetAttribute(&cus, hipDeviceAttributeMultiprocessorCount, dev);
    hipFuncSetAttribute((const void*)fwd_kernel, hipFuncAttributeMaxDynamicSharedMemorySize, LDS_BYTES);
    hipOccupancyMaxActiveBlocksPerMultiprocessor(&per_cu, (const void*)fwd_kernel, NTHR, LDS_BYTES);
    if (per_cu < 1) per_cu = 1;
    grid = cus * per_cu;
    if (grid > 256) grid = 256;
  }
  if (grid < 0) return;
  Params p{};
  for (int i = 0; i < 31; ++i) p.in[i] = (const float*)d_in[i];
  p.out = (float*)d_out; p.ws = (unsigned char*)d_ws;
  {
    int list[48]; int n = 0;
    for (int ph = 0; ph < N_PHASES; ++ph) {
      list[n++] = ph;
#ifdef REPQ
      if (ph < N_PHASES - 1 && (ph % PH_PER_LAYER) == REPQ) list[n++] = ph;
#endif
    }
#ifdef REPSYNC
    for (int i = 0; i < REPSYNC; ++i) list[n++] = 27;
#endif
    for (int i = 0; i < n; ++i) p.code[i / 12] |= (unsigned long long)list[i] << (5 * (i % 12));
    p.nph = n;
  }
  (void)hipMemsetAsync((unsigned char*)d_ws + WS_CTR, 0, 16384, stream);
  void* args[] = {&p};
  hipError_t e = hipLaunchCooperativeKernel((const void*)fwd_kernel, dim3(grid), dim3(NTHR), args, LDS_BYTES, stream);
  if (e != hipSuccess) fprintf(stderr, "cooperative launch failed: %s (grid %d)\n", hipGetErrorString(e), grid);
}
```

```cpp
#include <hip/hip_runtime.h>
#include <hip/hip_cooperative_groups.h>
#include <cstdio>
namespace cg = cooperative_groups;

#ifndef COOP
#define COOP 1
#endif

typedef unsigned short u16;
typedef unsigned int u32;
using bf16x8 = __attribute__((ext_vector_type(8))) short;
using f32x16 = __attribute__((ext_vector_type(16))) float;

constexpr int T = 16384;
constexpr int S = 8192;
constexpr int DM = 1024;
constexpr int IN_COLS = 8456;
constexpr int NPAD_IN = 8576;
constexpr int NMIX = 5504;
constexpr int DFF = 2816;
constexpr int NTHR = 512;

constexpr size_t U = 16777216;
constexpr size_t R_H = 0;
constexpr size_t R_UA = 2 * U;
constexpr size_t R_VA = 4 * U;
constexpr size_t R_Q = 6 * U;
constexpr size_t R_K = 7 * U;
constexpr size_t R_V = 8 * U;
constexpr size_t R_PC = 9 * U;
constexpr size_t R_LOGF = 12 * U + U / 2;
constexpr size_t R_CUM = R_LOGF + 524288;
constexpr size_t R_W = R_CUM + 524288;
constexpr size_t R_YB = 0;
constexpr size_t RW_R = 6 * U, RW_W = U, RW_K = 4 * U, RW_V = 5 * U, RW_A = 7 * U, RW_G = 8 * U;
constexpr size_t R_YC = U, R_H2 = 10 * U, R_MERGED = 7 * U;
constexpr size_t R_HF = 2 * U, R_ACT = 4 * U;
constexpr size_t WO_IN = 0;
constexpr size_t WO_PA = WO_IN + (size_t)NPAD_IN * 1024;
constexpr size_t WO_PB = WO_PA + 1024 * 1024;
constexpr size_t WO_PC = WO_PB + 1024 * 512;
constexpr size_t WO_OUT = WO_PC + 1024 * 512;
constexpr size_t WO_GU = WO_OUT + 1024 * 1024;
constexpr size_t WO_DN = WO_GU + (size_t)5632 * 1024;
constexpr size_t WO_WUP = WO_DN + (size_t)1024 * 2816;
constexpr size_t WO_AUP = WO_WUP + 512 * 64;
constexpr size_t WO_GUP = WO_AUP + 512 * 64;
constexpr size_t WO_VDN = WO_GUP + 512 * 128;
constexpr size_t WO_VUP = WO_VDN + 32 * 512;
constexpr size_t WO_END = WO_VUP + 512 * 64;
constexpr size_t R_VF = R_W + WO_END * 2;
constexpr size_t WS_CTR = R_VF + U;
constexpr size_t WS_END = WS_CTR + 16384;

constexpr int LDS_BYTES = 147456;

struct Params {
  const float* in[31];
  float* out;
  unsigned char* ws;
  unsigned long long code[4];
  int nph, pad;
};

enum { I_X = 0, I_NORM_MIX, I_W_IN, I_GATE_BIAS, I_A_LN_G, I_A_LN_B, I_A_W_S, I_A_B_S, I_B_F_BIAS, I_C_MU, I_C_W0, I_C_W_UP,
       I_C_A0, I_C_A_UP, I_C_G_UP, I_C_K_K, I_C_K_A, I_C_R_K, I_C_LNX_G, I_C_LNX_B, I_C_V0, I_C_V_DOWN, I_C_V_UP, I_P_A, I_P_B,
       I_P_C, I_W_OUT, I_NORM_FFN, I_W_GATE_UP, I_W_DOWN, I_NORM_FINAL };

__device__ __forceinline__ int opaque_tid() { int t = (int)__builtin_amdgcn_workitem_id_x(); asm volatile("" : "+v"(t)); return t; }
typedef __bf16 bf16x2_t __attribute__((ext_vector_type(2)));
typedef float f32x2_t __attribute__((ext_vector_type(2)));
__device__ __forceinline__ u32 pk2(float a, float b) {
  f32x2_t v = {a, b};
  return __builtin_bit_cast(u32, __builtin_convertvector(v, bf16x2_t));
}
__device__ __forceinline__ u16 f2bf(float f) { return (u16)(pk2(f, 0.f) & 0xffffu); }
__device__ __forceinline__ float bf2f(u16 h) { return __uint_as_float(((u32)h) << 16); }
__device__ __forceinline__ float bflo(u32 w) { return __uint_as_float(w << 16); }
__device__ __forceinline__ float bfhi(u32 w) { return __uint_as_float(w & 0xffff0000u); }
__device__ __forceinline__ float sigmoidf_(float x) { return __builtin_amdgcn_rcpf(1.f + __expf(-x)); }
__device__ __forceinline__ float gelu_tanh(float x) {
  float u = 0.7978845608028654f * (x + 0.044715f * x * x * x);
  return x * __builtin_amdgcn_rcpf(1.f + __expf(-2.f * u));
}
__device__ __forceinline__ float softplusf_(float x) { return fmaxf(x, 0.f) + __logf(1.f + __expf(-fabsf(x))); }
__device__ __forceinline__ float wave_sum(float v) {
#pragma unroll
  for (int o = 1; o < 64; o <<= 1) v += __shfl_xor(v, o);
  return v;
}
__device__ __forceinline__ float row16_sum(float v) {
  v += __int_as_float(__builtin_amdgcn_update_dpp(0, __float_as_int(v), 0xB1, 0xF, 0xF, false));
  v += __int_as_float(__builtin_amdgcn_update_dpp(0, __float_as_int(v), 0x4E, 0xF, 0xF, false));
  v += __int_as_float(__builtin_amdgcn_update_dpp(0, __float_as_int(v), 0x141, 0xF, 0xF, false));
  v += __int_as_float(__builtin_amdgcn_update_dpp(0, __float_as_int(v), 0x140, 0xF, 0xF, false));
  return v;
}

__device__ __forceinline__ float wave_sum_fast(float v) {
  v = row16_sum(v);
  const float s0 = __int_as_float(__builtin_amdgcn_readlane(__float_as_int(v), 0));
  const float s1 = __int_as_float(__builtin_amdgcn_readlane(__float_as_int(v), 16));
  const float s2 = __int_as_float(__builtin_amdgcn_readlane(__float_as_int(v), 32));
  const float s3 = __int_as_float(__builtin_amdgcn_readlane(__float_as_int(v), 48));
  return (s0 + s1) + (s2 + s3);
}
__device__ __forceinline__ int map_col(int kind, int np) {
  if (kind == 0) return np;
  if (kind == 1) { return np < 3592 ? np : (np < 3712 ? -1 : np - 120); }
  int grp = np >> 6, jj = np & 63;
  return jj < 32 ? 32 * grp + jj : DFF + 32 * grp + (jj - 32);
}
__device__ __forceinline__ void conv_item(const float* W, int K, int Nsrc, int Ndst, int kind, u16* Wt, float* scr, int item, int lane, int Kvalid = 1 << 30) {
  const int nblk = Ndst / 32, kb = item / nblk, nb = item % nblk, k0 = 64 * kb, n0 = 32 * nb;
  const int n = map_col(kind, n0 + (lane & 31));
  float tmpw[32];
#pragma unroll
  for (int i = 0; i < 32; ++i) {
    const int kk = 2 * i + (lane >> 5);
    tmpw[i] = (n >= 0 && k0 + kk < Kvalid) ? W[(size_t)(k0 + kk) * Nsrc + n] : 0.f;
  }
  __builtin_amdgcn_sched_barrier(0);
#pragma unroll
  for (int i = 0; i < 32; ++i) scr[(2 * i + (lane >> 5)) * 33 + (lane & 31)] = tmpw[i];
  __builtin_amdgcn_wave_barrier();
  __builtin_amdgcn_s_waitcnt(0xc07f);
  const int c = lane & 7;
#pragma unroll
  for (int j = 0; j < 4; ++j) {
    const int nn = (lane >> 3) + 8 * j;
    const float* s = scr + (8 * c) * 33 + nn;
    uint4 o;
    o.x = pk2(s[0 * 33], s[1 * 33]); o.y = pk2(s[2 * 33], s[3 * 33]); o.z = pk2(s[4 * 33], s[5 * 33]); o.w = pk2(s[6 * 33], s[7 * 33]);
    *(uint4*)(Wt + (size_t)(n0 + nn) * K + k0 + 8 * c) = o;
  }
  __builtin_amdgcn_wave_barrier();
  __builtin_amdgcn_s_waitcnt(0xc07f);
}

__device__ __forceinline__ void ph_convert(const Params& p, int l, unsigned char* smem, int bid, int nb, int part) {
  const int lane = opaque_tid() & 63, wave = opaque_tid() >> 6;
  float* scr = (float*)smem + wave * (64 * 33);
  u16* Wb = (u16*)(p.ws + R_W);
  const int gw = bid * 8 + wave, ngw = nb * 8;
  constexpr int I0 = 16 * (NPAD_IN / 32), I1 = 16 * 32, I2 = 8 * 32, I3 = 8 * 32, I4 = 16 * 32, I5 = 16 * (5632 / 32), I6 = 44 * 32;
  if (part == 0) {
    constexpr int NA = I0 + I1 + I2 + I3 + I4 + 16 + 16 + 32 + 8 + 16;
    for (int it = gw; it < NA; it += ngw) {
      int r = it;
      if (r < I0) { conv_item(p.in[I_W_IN] + (size_t)l * 1024 * IN_COLS, 1024, IN_COLS, NPAD_IN, 1, Wb + WO_IN, scr, r, lane); continue; } r -= I0;
      if (r < I1) { conv_item(p.in[I_P_A] + (size_t)l * 1024 * 1024, 1024, 1024, 1024, 0, Wb + WO_PA, scr, r, lane); continue; } r -= I1;
      if (r < I2) { conv_item(p.in[I_P_B] + (size_t)l * 512 * 1024, 512, 1024, 1024, 0, Wb + WO_PB, scr, r, lane); continue; } r -= I2;
      if (r < I3) { conv_item(p.in[I_P_C] + (size_t)l * 512 * 1024, 512, 1024, 1024, 0, Wb + WO_PC, scr, r, lane); continue; } r -= I3;
      if (r < I4) { conv_item(p.in[I_W_OUT] + (size_t)l * 1024 * 1024, 1024, 1024, 1024, 0, Wb + WO_OUT, scr, r, lane); continue; } r -= I4;
      if (r < 16) { conv_item(p.in[I_C_W_UP] + (size_t)l * 64 * 512, 64, 512, 512, 0, Wb + WO_WUP, scr, r, lane); continue; } r -= 16;
      if (r < 16) { conv_item(p.in[I_C_A_UP] + (size_t)l * 64 * 512, 64, 512, 512, 0, Wb + WO_AUP, scr, r, lane); continue; } r -= 16;
      if (r < 32) { conv_item(p.in[I_C_G_UP] + (size_t)l * 128 * 512, 128, 512, 512, 0, Wb + WO_GUP, scr, r, lane); continue; } r -= 32;
      if (l == 0) continue;
      if (r < 8) { conv_item(p.in[I_C_V_DOWN] + (size_t)(l - 1) * 512 * 32, 512, 32, 32, 0, Wb + WO_VDN, scr, r, lane); continue; } r -= 8;
      conv_item(p.in[I_C_V_UP] + (size_t)(l - 1) * 32 * 512, 64, 512, 512, 0, Wb + WO_VUP, scr, r, lane, 32);
    }
  } else {
    for (int it = gw; it < I5 + I6; it += ngw) {
      int r = it;
      if (r < I5) { conv_item(p.in[I_W_GATE_UP] + (size_t)l * 1024 * 5632, 1024, 5632, 5632, 2, Wb + WO_GU, scr, r, lane); continue; } r -= I5;
      conv_item(p.in[I_W_DOWN] + (size_t)l * DFF * 1024, DFF, 1024, 1024, 0, Wb + WO_DN, scr, r, lane);
    }
  }
}

__device__ __forceinline__ void ph_rmsnorm(const float* src, const float* g, u16* dst, float* dstf, int widx, int nw) {
  const int lane = opaque_tid() & 63;
  float4 gg[4];
#pragma unroll
  for (int j = 0; j < 4; ++j) gg[j] = *(const float4*)(g + 4 * lane + 256 * j);
  for (int row0 = widx; row0 < T; row0 += 4 * nw) {
    float4 v[4][4];
#pragma unroll
    for (int u = 0; u < 4; ++u) {
      const int row = (row0 + u * nw < T) ? row0 + u * nw : widx;
#pragma unroll
      for (int j = 0; j < 4; ++j) v[u][j] = *(const float4*)(src + (size_t)row * 1024 + 4 * lane + 256 * j);
    }
    __builtin_amdgcn_sched_barrier(0);
#pragma unroll
    for (int u = 0; u < 4; ++u) {
      const int row = row0 + u * nw;
      float s = 0.f;
#pragma unroll
      for (int j = 0; j < 4; ++j) s += (v[u][j].x * v[u][j].x + v[u][j].y * v[u][j].y) + (v[u][j].z * v[u][j].z + v[u][j].w * v[u][j].w);
      s = wave_sum_fast(s);
      const float rs = rsqrtf(s * (1.f / 1024.f) + 1e-6f);
      if (row < T) {
#pragma unroll
        for (int j = 0; j < 4; ++j) {
          const float a = v[u][j].x * rs * gg[j].x, b2 = v[u][j].y * rs * gg[j].y, c = v[u][j].z * rs * gg[j].z, d = v[u][j].w * rs * gg[j].w;
          if (dstf) *(float4*)(dstf + (size_t)row * 1024 + 4 * lane + 256 * j) = make_float4(a, b2, c, d);
          else { uint2 o; o.x = pk2(a, b2); o.y = pk2(c, d); *(uint2*)(dst + (size_t)row * 1024 + 4 * lane + 256 * j) = o; }
        }
      }
    }
  }
}

constexpr int LROW = 72;
constexpr int STAGE_ELEMS = (256 + 128) * LROW;

typedef unsigned int v4u __attribute__((ext_vector_type(4)));
struct GkRegs { v4u a0, a1, a2, a3, b0, b1; };
#define GK_LOAD(R, KT)                                                          \
  {                                                                             \
    const u16* pa_ = A + (size_t)lrow * lda + (KT) * 64 + lkc;                  \
    const u16* pb_ = B + (size_t)lrow * ldb + (KT) * 64 + lkc;                  \
    R.a0 = *(const v4u*)(pa_);                                                \
    R.a1 = *(const v4u*)(pa_ + (size_t)64 * lda);                             \
    R.a2 = *(const v4u*)(pa_ + (size_t)128 * lda);                            \
    R.a3 = *(const v4u*)(pa_ + (size_t)192 * lda);                            \
    R.b0 = *(const v4u*)(pb_);                                                \
    R.b1 = *(const v4u*)(pb_ + (size_t)64 * ldb);                             \
  }
#define GK_WRITE(R, BUF)                                                        \
  {                                                                             \
    u16* wa_ = smem + (BUF) * STAGE_ELEMS + lrow * LROW + lkc;                  \
    u16* wb_ = wa_ + 256 * LROW;                                                \
    *(v4u*)(wa_) = R.a0;                                                      \
    *(v4u*)(wa_ + 64 * LROW) = R.a1;                                          \
    *(v4u*)(wa_ + 128 * LROW) = R.a2;                                         \
    *(v4u*)(wa_ + 192 * LROW) = R.a3;                                         \
    *(v4u*)(wb_) = R.b0;                                                      \
    *(v4u*)(wb_ + 64 * LROW) = R.b1;                                          \
  }
#define GK_COMPUTE(BUF)                                                                                                 \
  {                                                                                                                     \
    const u16* sa_ = smem + (BUF) * STAGE_ELEMS; const u16* sb_ = sa_ + 256 * LROW;                                     \
    _Pragma("unroll") for (int s = 0; s < 4; ++s) {                                                                     \
      bf16x8 af[2], bfr[2];                                                                                             \
      _Pragma("unroll") for (int i = 0; i < 2; ++i) af[i] = *(const bf16x8*)(sa_ + (wm * 64 + i * 32 + r) * LROW + s * 16 + h * 8);  \
      _Pragma("unroll") for (int j = 0; j < 2; ++j) bfr[j] = *(const bf16x8*)(sb_ + (wn * 64 + j * 32 + r) * LROW + s * 16 + h * 8); \
      _Pragma("unroll") for (int i = 0; i < 2; ++i) _Pragma("unroll") for (int j = 0; j < 2; ++j)                       \
        acc[i][j] = __builtin_amdgcn_mfma_f32_32x32x16_bf16(af[i], bfr[j], acc[i][j], 0, 0, 0);                         \
    }                                                                                                                   \
  }
#ifndef GEMM_DMA
#define GEMM_DMA 1
#endif
#if GEMM_DMA
constexpr int DS_A = 256 * 64, DS_STAGE = (256 + 128) * 64;
__device__ __forceinline__ void gd_issue(const u16* __restrict__ A, int lda, const u16* __restrict__ B, int ldb, int kt, int st, u16* smem, int lane, int wave) {
  const int drow = lane >> 3;
  const int rowA = wave * 32 + drow, rowB = wave * 16 + drow;
  const u16* gA0 = A + (size_t)rowA * lda + (((lane & 7) ^ ((rowA >> 1) & 7)) * 8) + kt * 64;
  const u16* gA1 = A + (size_t)(rowA + 8) * lda + (((lane & 7) ^ (((rowA + 8) >> 1) & 7)) * 8) + kt * 64;
  const u16* gB0 = B + (size_t)rowB * ldb + (((lane & 7) ^ ((rowB >> 1) & 7)) * 8) + kt * 64;
  const u16* gB1 = B + (size_t)(rowB + 8) * ldb + (((lane & 7) ^ (((rowB + 8) >> 1) & 7)) * 8) + kt * 64;
  u16* sA_ = smem + st * DS_STAGE + wave * 32 * 64;
  u16* sB_ = smem + st * DS_STAGE + DS_A + wave * 16 * 64;
  __builtin_amdgcn_global_load_lds((const unsigned*)(gA0), (unsigned*)(sA_), 16, 0, 0);
  __builtin_amdgcn_global_load_lds((const unsigned*)(gA1), (unsigned*)(sA_ + 8 * 64), 16, 0, 0);
  __builtin_amdgcn_global_load_lds((const unsigned*)(gA0 + (size_t)16 * lda), (unsigned*)(sA_ + 16 * 64), 16, 0, 0);
  __builtin_amdgcn_global_load_lds((const unsigned*)(gA1 + (size_t)16 * lda), (unsigned*)(sA_ + 24 * 64), 16, 0, 0);
  __builtin_amdgcn_global_load_lds((const unsigned*)(gB0), (unsigned*)(sB_), 16, 0, 0);
  __builtin_amdgcn_global_load_lds((const unsigned*)(gB1), (unsigned*)(sB_ + 8 * 64), 16, 0, 0);
}
__device__ __forceinline__ void gemm_prefetch(const u16* __restrict__ A, int lda, const u16* __restrict__ B, int ldb, int K, u16* smem) {
  const int tid = opaque_tid(), lane = tid & 63, wave = __builtin_amdgcn_readfirstlane(tid >> 6);
  gd_issue(A, lda, B, ldb, 0, 0, smem, lane, wave);
  gd_issue(A, lda, B, ldb, (K > 64 ? 1 : 0), 1, smem, lane, wave);
}
__device__ __forceinline__ void gemm_kloop(const u16* __restrict__ A, int lda, const u16* __restrict__ B, int ldb, int K,
                                           f32x16 (&acc)[2][2], u16* smem, bool prefetched = false, bool pipe = true) {
  const int tid = opaque_tid(), lane = tid & 63, wave = __builtin_amdgcn_readfirstlane(tid >> 6);
  const int wm = wave >> 1, wn = wave & 1, r = lane & 31, h = lane >> 5;
  const int nk = K >> 6;
  const int key = (r >> 1) & 7;
  if (!prefetched) {
    gd_issue(A, lda, B, ldb, 0, 0, smem, lane, wave);
    gd_issue(A, lda, B, ldb, (nk > 1 ? 1 : 0), 1, smem, lane, wave);
  }
  int st = 0;
  for (int kt = 0; kt < nk; ++kt) {
    __builtin_amdgcn_sched_barrier(0);
    if (kt + 1 < nk) asm volatile("s_waitcnt vmcnt(6)" ::: "memory"); else asm volatile("s_waitcnt vmcnt(0)" ::: "memory");
    __builtin_amdgcn_s_barrier();
    __builtin_amdgcn_sched_barrier(0);
    if (kt + 2 < nk) {
      const int st2 = (st >= 1) ? st - 1 : 2;
      gd_issue(A, lda, B, ldb, kt + 2, st2, smem, lane, wave);
    }
    const u16* sa_ = smem + st * DS_STAGE + (wm * 64 + r) * 64;
    const u16* sb_ = smem + st * DS_STAGE + DS_A + (wn * 64 + r) * 64;
    if (pipe) {
    bf16x8 af[2][2], bfr[2][2];
    {
      const int co = ((0 + h) ^ key) * 8;
#pragma unroll
      for (int i = 0; i < 2; ++i) af[0][i] = *(const bf16x8*)(sa_ + i * 32 * 64 + co);
#pragma unroll
      for (int j = 0; j < 2; ++j) bfr[0][j] = *(const bf16x8*)(sb_ + j * 32 * 64 + co);
    }
#pragma unroll
    for (int s4 = 0; s4 < 4; ++s4) {
      if (s4 < 3) {
        const int co = ((2 * (s4 + 1) + h) ^ key) * 8;
#pragma unroll
        for (int i = 0; i < 2; ++i) af[(s4 + 1) & 1][i] = *(const bf16x8*)(sa_ + i * 32 * 64 + co);
#pragma unroll
        for (int j = 0; j < 2; ++j) bfr[(s4 + 1) & 1][j] = *(const bf16x8*)(sb_ + j * 32 * 64 + co);
      }
#pragma unroll
      for (int i = 0; i < 2; ++i)
#pragma unroll
        for (int j = 0; j < 2; ++j) acc[i][j] = __builtin_amdgcn_mfma_f32_32x32x16_bf16(af[s4 & 1][i], bfr[s4 & 1][j], acc[i][j], 0, 0, 0);
    }
    __builtin_amdgcn_sched_group_barrier(0x100, 8, 0);
    __builtin_amdgcn_sched_group_barrier(0x008, 4, 0);
    __builtin_amdgcn_sched_group_barrier(0x100, 4, 0);
    __builtin_amdgcn_sched_group_barrier(0x008, 4, 0);
    __builtin_amdgcn_sched_group_barrier(0x100, 4, 0);
    __builtin_amdgcn_sched_group_barrier(0x008, 8, 0);
    } else {
#pragma unroll
      for (int s4 = 0; s4 < 4; ++s4) {
        const int co = ((2 * s4 + h) ^ key) * 8;
        bf16x8 af1[2], bfr1[2];
#pragma unroll
        for (int i = 0; i < 2; ++i) af1[i] = *(const bf16x8*)(sa_ + i * 32 * 64 + co);
#pragma unroll
        for (int j = 0; j < 2; ++j) bfr1[j] = *(const bf16x8*)(sb_ + j * 32 * 64 + co);
#pragma unroll
        for (int i = 0; i < 2; ++i)
#pragma unroll
          for (int j = 0; j < 2; ++j) acc[i][j] = __builtin_amdgcn_mfma_f32_32x32x16_bf16(af1[i], bfr1[j], acc[i][j], 0, 0, 0);
      }
    }
    st = (st == 2) ? 0 : st + 1;
  }
  asm volatile("s_waitcnt lgkmcnt(0)" ::: "memory");
  __builtin_amdgcn_s_barrier();
}
#else
__device__ __forceinline__ void gemm_kloop(const u16* __restrict__ A, int lda, const u16* __restrict__ B, int ldb, int K,
                                           f32x16 (&acc)[2][2], u16* smem) {
  const int tid = opaque_tid(), lane = tid & 63, wave = tid >> 6;
  const int wm = wave >> 1, wn = wave & 1, r = lane & 31, h = lane >> 5;
  const int lrow = tid >> 3, lkc = (tid & 7) * 8;
  GkRegs g0, g1;
  const int nk = K >> 6;
  GK_LOAD(g0, 0)
  GK_LOAD(g1, (nk > 1 ? 1 : 0))
  GK_WRITE(g0, 0)
  __syncthreads();
  for (int kt = 0; kt < nk; kt += 2) {
    GK_LOAD(g0, (kt + 2 < nk ? kt + 2 : nk - 1))
    GK_COMPUTE(0)
    GK_WRITE(g1, 1)
    __syncthreads();
    GK_LOAD(g1, (kt + 3 < nk ? kt + 3 : nk - 1))
    GK_COMPUTE(1)
    GK_WRITE(g0, 0)
    __syncthreads();
  }
}
#endif
__device__ __forceinline__ void acc_zero(f32x16 (&acc)[2][2]) {
#pragma unroll
  for (int i = 0; i < 2; ++i)
#pragma unroll
    for (int j = 0; j < 2; ++j)
#pragma unroll
      for (int e = 0; e < 16; ++e) acc[i][j][e] = 0.f;
}
__device__ __forceinline__ void tile_decode(int t, int NT, int& mt, int& nt) {
  const int g = t / (16 * NT), rem = t % (16 * NT);
  nt = rem / 16; mt = g * 16 + (rem % 16);
}
#define EPI_LOOP(i, j, e) \
  _Pragma("unroll") for (int i = 0; i < 2; ++i) _Pragma("unroll") for (int j = 0; j < 2; ++j) _Pragma("unroll") for (int e = 0; e < 16; ++e)

__device__ __forceinline__ void ph_inproj(const Params& p, int l, unsigned char* smem, int bid, int nb) {
  const u16* H = (const u16*)(p.ws + R_H);
  const u16* Wt = (const u16*)(p.ws + R_W) + WO_IN;
  const int lane = opaque_tid() & 63, wave = opaque_tid() >> 6, wm = wave >> 1, wn = wave & 1, r = lane & 31, h = lane >> 5;
  constexpr int NT = NMIX / 128;
  bool pf = false;
  for (int t = bid; t < 64 * NT; t += nb) {
    int mt, nt; tile_decode(t, NT, mt, nt);
    const int m0 = mt * 256, n0 = nt * 128;
    f32x16 acc[2][2]; acc_zero(acc);
    gemm_kloop(H + (size_t)m0 * 1024, 1024, Wt + (size_t)n0 * 1024, 1024, 1024, acc, (u16*)smem, pf);
    pf = (t + nb < 64 * NT);
    if (pf) { int mt2, nt2; tile_decode(t + nb, NT, mt2, nt2); gemm_prefetch(H + (size_t)mt2 * 256 * 1024, 1024, Wt + (size_t)nt2 * 128 * 1024, 1024, 1024, (u16*)smem); }
    if (n0 < 2048) {
      u16* dst = (u16*)(p.ws + (n0 < 1024 ? R_UA : R_VA));
      const int nb0 = (n0 & 1023) + wn * 64 + r;
      EPI_LOOP(i, j, e) {
        const int m = m0 + wm * 64 + i * 32 + (e & 3) + 8 * (e >> 2) + 4 * h;
        dst[(size_t)m * 1024 + nb0 + j * 32] = f2bf(gelu_tanh(acc[i][j][e]));
      }
    } else if (n0 < 3584) {
      const int seg = (n0 - 2048) >> 9;
      u16* dst = (u16*)(p.ws + (seg == 0 ? R_Q : (seg == 1 ? R_K : R_V)));
      const int nb0 = ((n0 - 2048) & 511) + wn * 64 + r;
      EPI_LOOP(i, j, e) {
        const int m = m0 + wm * 64 + i * 32 + (e & 3) + 8 * (e >> 2) + 4 * h;
        dst[(size_t)m * 512 + nb0 + j * 32] = f2bf(acc[i][j][e]);
      }
    } else if (n0 < 3712) {
      if (wn == 0 && r < 8) {
        float* dst = (float*)(p.ws + R_LOGF);
        const float bfv = p.in[I_B_F_BIAS][l * 8 + r];
#pragma unroll
        for (int i = 0; i < 2; ++i)
#pragma unroll
          for (int e = 0; e < 16; ++e) {
            const int m = m0 + wm * 64 + i * 32 + (e & 3) + 8 * (e >> 2) + 4 * h;
            const float z = acc[i][0][e] + bfv;
            dst[(size_t)m * 8 + r] = -softplusf_(-z);
          }
      }
    } else {
      u16* dst = (u16*)(p.ws + R_PC);
      const int nb0 = (n0 - 3712) + wn * 64 + r;
      EPI_LOOP(i, j, e) {
        const int m = m0 + wm * 64 + i * 32 + (e & 3) + 8 * (e >> 2) + 4 * h;
        dst[(size_t)m * 1792 + nb0 + j * 32] = f2bf(acc[i][j][e]);
      }
    }
  }
}

constexpr int MA_ROW = 136;
__device__ __forceinline__ void mixerA_item(const Params& p, int l, unsigned char* smem, int item) {
  const int c = item >> 2, g = item & 3, tok0 = c * 128, ch0 = g * 256;
  const int tid = opaque_tid(), lane = tid & 63, wave = tid >> 6, r = lane & 31, h = lane >> 5;
  float* stats = (float*)smem;
  u16* Wm = (u16*)(smem + 1024);
  u16* Vt = Wm + 128 * MA_ROW;
  const u16* va = (const u16*)(p.ws + R_VA);
  u16* ua = (u16*)(p.ws + R_UA);
  {
    const int tok = tid >> 2, part = tid & 3;
    const u16* row = va + (size_t)(tok0 + tok) * 1024;
    float s = 0.f, s2 = 0.f;
#pragma unroll 4
    for (int i = 0; i < 32; ++i) {
      const uint4 q = *(const uint4*)(row + (i * 4 + part) * 8);
      const u32 w[4] = {q.x, q.y, q.z, q.w};
#pragma unroll
      for (int e = 0; e < 4; ++e) { const float a = bflo(w[e]), b = bfhi(w[e]); s += a + b; s2 += a * a + b * b; }
    }
    s += __shfl_xor(s, 1); s2 += __shfl_xor(s2, 1);
    s += __shfl_xor(s, 2); s2 += __shfl_xor(s2, 2);
    if (part == 0) {
      const float mu = s * (1.f / 1024.f);
      const float var = fmaxf(s2 * (1.f / 1024.f) - mu * mu, 0.f);
      stats[tok * 2] = mu; stats[tok * 2 + 1] = rsqrtf(var + 1e-5f);
    }
  }
  {
    const int t = tid >> 2, s0 = (tid & 3) * 32;
    const float* wsrc = p.in[I_A_W_S] + ((size_t)(l * 4 + g) * 128 + t) * 128 + s0;
#pragma unroll
    for (int q4 = 0; q4 < 4; ++q4) {
      float f[8];
      *(float4*)&f[0] = *(const float4*)(wsrc + q4 * 8);
      *(float4*)&f[4] = *(const float4*)(wsrc + q4 * 8 + 4);
#pragma unroll
      for (int e = 0; e < 8; ++e) if (s0 + q4 * 8 + e > t) f[e] = 0.f;
      uint4 o; o.x = pk2(f[0], f[1]); o.y = pk2(f[2], f[3]); o.z = pk2(f[4], f[5]); o.w = pk2(f[6], f[7]);
      *(uint4*)(Wm + t * MA_ROW + s0 + q4 * 8) = o;
    }
  }
  __syncthreads();
  {
    const float* lng = p.in[I_A_LN_G] + l * 1024 + ch0;
    const float* lnb = p.in[I_A_LN_B] + l * 1024 + ch0;
#pragma unroll
    for (int i = 0; i < 8; ++i) {
      const int cc = tid + 512 * i, tok = cc >> 5, cg8 = (cc & 31) * 8;
      const uint4 q = *(const uint4*)(va + (size_t)(tok0 + tok) * 1024 + ch0 + cg8);
      const float mu = stats[tok * 2], rs = stats[tok * 2 + 1];
      const u32 w[4] = {q.x, q.y, q.z, q.w};
#pragma unroll
      for (int e = 0; e < 4; ++e) {
        const int d0 = cg8 + 2 * e;
        const float a = (bflo(w[e]) - mu) * rs * lng[d0] + lnb[d0];
        const float b = (bfhi(w[e]) - mu) * rs * lng[d0 + 1] + lnb[d0 + 1];
        Vt[d0 * MA_ROW + tok] = f2bf(a);
        Vt[(d0 + 1) * MA_ROW + tok] = f2bf(b);
      }
    }
  }
  __syncthreads();
  f32x16 acc[4];
#pragma unroll
  for (int ti = 0; ti < 4; ++ti)
#pragma unroll
    for (int e = 0; e < 16; ++e) acc[ti][e] = 0.f;
#pragma unroll
  for (int ks = 0; ks < 8; ++ks) {
    const bf16x8 b = *(const bf16x8*)(Vt + (wave * 32 + r) * MA_ROW + ks * 16 + h * 8);
#pragma unroll
    for (int ti = 0; ti < 4; ++ti) {
      if (16 * ks <= 32 * ti + 31) {
        const bf16x8 a = *(const bf16x8*)(Wm + (ti * 32 + r) * MA_ROW + ks * 16 + h * 8);
        acc[ti] = __builtin_amdgcn_mfma_f32_32x32x16_bf16(a, b, acc[ti], 0, 0, 0);
      }
    }
  }
  {
    const float* bs = p.in[I_A_B_S] + (size_t)(l * 4 + g) * 128;
    const int ch = ch0 + wave * 32 + r;
    float uv[4][16], bsv[4][16];
#pragma unroll
    for (int ti = 0; ti < 4; ++ti)
#pragma unroll
      for (int e = 0; e < 16; ++e) {
        const int t = ti * 32 + (e & 3) + 8 * (e >> 2) + 4 * h;
        uv[ti][e] = bf2f(ua[(size_t)(tok0 + t) * 1024 + ch]);
        bsv[ti][e] = bs[t];
      }
    __builtin_amdgcn_sched_barrier(0);
#pragma unroll
    for (int ti = 0; ti < 4; ++ti)
#pragma unroll
      for (int e = 0; e < 16; ++e) {
        const int t = ti * 32 + (e & 3) + 8 * (e >> 2) + 4 * h;
        ua[(size_t)(tok0 + t) * 1024 + ch] = f2bf(uv[ti][e] * (acc[ti][e] + bsv[ti][e]));
      }
  }
  __syncthreads();
}
__device__ __forceinline__ void cumsum_item(const Params& p, unsigned char* smem, int bh) {
  const int b = bh >> 3, hh = bh & 7, tid = opaque_tid();
  const float* logf_ = (const float*)(p.ws + R_LOGF);
  float* cum = (float*)(p.ws + R_CUM) + (size_t)bh * S;
  float* part = (float*)smem;
  float v[16]; float s = 0.f;
#pragma unroll
  for (int i = 0; i < 16; ++i) { v[i] = logf_[(size_t)(b * S + tid * 16 + i) * 8 + hh]; s += v[i]; }
  part[tid] = s;
  __syncthreads();
  float pre = 0.f;
  for (int i = 0; i < tid; ++i) pre += part[i];
#pragma unroll
  for (int i = 0; i < 16; ++i) { pre += v[i]; cum[tid * 16 + i] = pre; }
  __syncthreads();
}
__device__ __forceinline__ void ph_mixerA(const Params& p, int l, unsigned char* smem, int bid, int nb) {
  for (int it = bid; it < 16; it += nb) cumsum_item(p, smem, it);
}

constexpr int AT_KROW = 72;
constexpr float AT_SKIP = 250.f;
constexpr int AT_STAGE = 64 * AT_KROW * 2 * 2 + 256;
__device__ __forceinline__ void attn_item(const Params& p, unsigned char* smem, int qb, int bh) {
  const int b = bh >> 3, hh = bh & 7;
  const int tid = opaque_tid(), lane = tid & 63, wave = tid >> 6, r = lane & 31, h = lane >> 5;
  const u16* Q = (const u16*)(p.ws + R_Q);
  const u16* Kg = (const u16*)(p.ws + R_K);
  const u16* Vg = (const u16*)(p.ws + R_V);
  u16* Yb = (u16*)(p.ws + R_YB);
  const float* cum = (const float*)(p.ws + R_CUM) + (size_t)bh * S;
  const int q0w = qb * 256 + wave * 32;
  const size_t tokq = (size_t)b * S + q0w + r;
  const float LOG2E = 1.4426950408889634f;
  const float cq0 = cum[qb * 256];
  bf16x8 qf[4];
#pragma unroll
  for (int s = 0; s < 4; ++s) qf[s] = *(const bf16x8*)(Q + tokq * 512 + hh * 64 + s * 16 + h * 8);
  f32x16 accO[2];
#pragma unroll
  for (int d = 0; d < 2; ++d)
#pragma unroll
    for (int e = 0; e < 16; ++e) accO[d][e] = 0.f;
  float mrun = -INFINITY, lrun = 0.f;
  const int nkt = 4 * (qb + 1);
  const int skey = tid >> 3, sdc = (tid & 7) * 8;
  const int vkey = tid & 63, vdc = (tid >> 6) * 8;
  uint4 rk, rv; float rc = 0.f;
  unsigned* cntw = (unsigned*)(smem + 2 * AT_STAGE);
  if (tid == 0) *cntw = 0u;
  __syncthreads();
  if (tid < nkt && (cq0 - cum[tid * 64 + 63]) * LOG2E < -AT_SKIP) atomicAdd(cntw, 1u);
  __syncthreads();
  const int kt0 = (int)*cntw;
  {
    const size_t tk = ((size_t)b * S + (nkt - 1) * 64 + skey) * 512 + hh * 64 + sdc;
    rk = *(const uint4*)(Kg + tk); rv = *(const uint4*)(Vg + ((size_t)b * S + (nkt - 1) * 64 + vkey) * 512 + hh * 64 + vdc);
    if (tid < 64) rc = cum[(nkt - 1) * 64 + tid];
  }
  auto swrite = [&](int buf) {
    u16* Ks = (u16*)(smem + buf * AT_STAGE);
    u16* Vt = Ks + 64 * AT_KROW;
    float* bias = (float*)(smem + buf * AT_STAGE + 64 * AT_KROW * 4);
    *(uint4*)(Ks + skey * AT_KROW + sdc) = rk;
    const u32 w[4] = {rv.x, rv.y, rv.z, rv.w};
#pragma unroll
    for (int e = 0; e < 4; ++e) {
      Vt[(vdc + 2 * e) * AT_KROW + vkey] = (u16)(w[e] & 0xffffu);
      Vt[(vdc + 2 * e + 1) * AT_KROW + vkey] = (u16)(w[e] >> 16);
    }
    if (tid < 64) bias[tid] = (cq0 - rc) * 8.f;
  };
  swrite((nkt - 1) & 1);
  __syncthreads();
  for (int kt = nkt - 1; kt >= kt0; --kt) {
    const bool more = (kt - 1 >= kt0);
    if (more) {
      const size_t tk = ((size_t)b * S + (kt - 1) * 64 + skey) * 512 + hh * 64 + sdc;
      rk = *(const uint4*)(Kg + tk); rv = *(const uint4*)(Vg + ((size_t)b * S + (kt - 1) * 64 + vkey) * 512 + hh * 64 + vdc);
      if (tid < 64) rc = cum[(kt - 1) * 64 + tid];
    }
    if (kt * 64 <= q0w + 31) {
      const u16* Ks = (const u16*)(smem + (kt & 1) * AT_STAGE);
      const u16* Vt = Ks + 64 * AT_KROW;
      const float* bias = (const float*)(smem + (kt & 1) * AT_STAGE + 64 * AT_KROW * 4);
      f32x16 sc[2];
#pragma unroll
      for (int sub = 0; sub < 2; ++sub) {
#pragma unroll
        for (int e4 = 0; e4 < 4; ++e4) {
          const float4 bb = *(const float4*)(bias + sub * 32 + 8 * e4 + 4 * h);
          sc[sub][e4 * 4 + 0] = bb.x; sc[sub][e4 * 4 + 1] = bb.y; sc[sub][e4 * 4 + 2] = bb.z; sc[sub][e4 * 4 + 3] = bb.w;
        }
#pragma unroll
        for (int s = 0; s < 4; ++s) {
          const bf16x8 a = *(const bf16x8*)(Ks + (sub * 32 + r) * AT_KROW + s * 16 + h * 8);
          sc[sub] = __builtin_amdgcn_mfma_f32_32x32x16_bf16(a, qf[s], sc[sub], 0, 0, 0);
        }
      }
      const bool diag = (kt * 64 + 63 > q0w);
      const int qpos = q0w + r;
      float mx = -INFINITY;
      if (diag) {
        asm volatile("" ::: "memory");
#pragma unroll
        for (int sub = 0; sub < 2; ++sub)
#pragma unroll
          for (int e = 0; e < 16; ++e)
            if (kt * 64 + sub * 32 + (e & 3) + 8 * (e >> 2) + 4 * h > qpos) sc[sub][e] = -INFINITY;
      }
#pragma unroll
      for (int sub = 0; sub < 2; ++sub)
#pragma unroll
        for (int e = 0; e < 16; ++e) mx = fmaxf(mx, sc[sub][e]);
      mx = fmaxf(mx, __shfl_xor(mx, 32));
      const float mnew = fmaxf(mrun, mx * (0.125f * LOG2E));
      const bool resc = __builtin_amdgcn_ballot_w64(mnew != mrun) != 0ull;
      const float mold = mrun;
      mrun = mnew;
      float ls = 0.f;
      bf16x8 pf[2][2];
#pragma unroll
      for (int sub = 0; sub < 2; ++sub)
#pragma unroll
        for (int s2 = 0; s2 < 2; ++s2) {
          float pv[8];
#pragma unroll
          for (int j = 0; j < 8; ++j) { pv[j] = __builtin_amdgcn_exp2f(__builtin_fmaf(sc[sub][8 * s2 + j], 0.125f * LOG2E, -mnew)); ls += pv[j]; }
          union { bf16x8 v; u32 w[4]; } cv;
          cv.w[0] = pk2(pv[0], pv[1]); cv.w[1] = pk2(pv[2], pv[3]); cv.w[2] = pk2(pv[4], pv[5]); cv.w[3] = pk2(pv[6], pv[7]);
          pf[sub][s2] = cv.v;
        }
      if (resc) {
        const float alpha = __builtin_amdgcn_exp2f(mold - mnew);
        lrun *= alpha;
#pragma unroll
        for (int d = 0; d < 2; ++d)
#pragma unroll
          for (int e = 0; e < 16; ++e) accO[d][e] *= alpha;
      }
      lrun += ls;
#pragma unroll
      for (int d = 0; d < 2; ++d) {
#pragma unroll
        for (int sub = 0; sub < 2; ++sub)
#pragma unroll
          for (int s2 = 0; s2 < 2; ++s2) {
            const u16* vp = Vt + (d * 32 + r) * AT_KROW + sub * 32 + 16 * s2 + 4 * h;
            union { bf16x8 v; uint2 w[2]; } av;
            av.w[0] = *(const uint2*)(vp);
            av.w[1] = *(const uint2*)(vp + 8);
            accO[d] = __builtin_amdgcn_mfma_f32_32x32x16_bf16(av.v, pf[sub][s2], accO[d], 0, 0, 0);
          }
      }
    }
    if (more) swrite((kt - 1) & 1);
    __syncthreads();
  }
  const float ltot = lrun + __shfl_xor(lrun, 32);
  const float inv = 1.f / ltot;
#pragma unroll
  for (int d = 0; d < 2; ++d)
#pragma unroll
    for (int e4 = 0; e4 < 4; ++e4) {
      const int dd = d * 32 + 8 * e4 + 4 * h;
      uint2 o;
      o.x = pk2(accO[d][e4 * 4 + 0] * inv, accO[d][e4 * 4 + 1] * inv);
      o.y = pk2(accO[d][e4 * 4 + 2] * inv, accO[d][e4 * 4 + 3] * inv);
      *(uint2*)(Yb + tokq * 512 + hh * 64 + dd) = o;
    }
}
__device__ __forceinline__ void ph_attn(const Params& p, int l, unsigned char* smem, int bid, int nb) {
  unsigned* qw = (unsigned*)(p.ws + WS_CTR) + 3600 + 64 * l;
  int* nxt = (int*)(smem + 2 * AT_STAGE + 16);
  for (;;) {
    if (opaque_tid() == 0) *nxt = (int)__hip_atomic_fetch_add(qw, 1u, __ATOMIC_RELAXED, __HIP_MEMORY_SCOPE_AGENT);
    __syncthreads();
    const int idx = *nxt;
    __syncthreads();
    if (idx >= 1024) break;
    if (idx < 512) attn_item(p, smem, 31 - (idx >> 4), idx & 15);
    else mixerA_item(p, l, smem, idx - 512);
  }
}

constexpr int PXW = 72, PXG = 136, PXV = 520, PXD = 40;
__device__ __forceinline__ void prep_item(const Params& p, int l, unsigned char* smem, int item) {
  const int tok0 = item * 32, tid = opaque_tid();
  const int lane = tid & 63, wave = tid >> 6, r = lane & 31, h = lane >> 5;
  u16* XW = (u16*)smem;
  u16* XA = XW + 32 * PXW;
  u16* XG = XA + 32 * PXW;
  u16* XV = XG + 32 * PXG;
  u16* XD = XV + 32 * PXV;
  float* VDP = (float*)(XD + 32 * PXD);
  const u16* pc = (const u16*)(p.ws + R_PC);
  const float* mu = p.in[I_C_MU] + l * 1792;
  const u16* Wb = (const u16*)(p.ws + R_W);
  u16* oR = (u16*)(p.ws + RW_R); u16* oW = (u16*)(p.ws + RW_W); u16* oK = (u16*)(p.ws + RW_K);
  u16* oV = (u16*)(p.ws + RW_V); u16* oA = (u16*)(p.ws + RW_A); u16* oG = (u16*)(p.ws + RW_G);
  u16* vf = (u16*)(p.ws + R_VF);
#pragma unroll 1
  for (int i2 = 0; i2 < 14; i2 += 2) {
    uint4 curv[2], prvv[2]; float4 muA[2], muB[2];
#pragma unroll
    for (int u = 0; u < 2; ++u) {
      const int cc = tid + 512 * (i2 + u), tt = cc / 224, c8 = (cc % 224) * 8;
      const int tok = tok0 + tt;
      curv[u] = *(const uint4*)(pc + (size_t)tok * 1792 + c8);
      prvv[u] = make_uint4(0, 0, 0, 0);
      if ((tok & (S - 1)) != 0) prvv[u] = *(const uint4*)(pc + (size_t)(tok - 1) * 1792 + c8);
      muA[u] = *(const float4*)(mu + c8); muB[u] = *(const float4*)(mu + c8 + 4);
    }
    __builtin_amdgcn_sched_barrier(0);
#pragma unroll
    for (int u = 0; u < 2; ++u) {
    const int cc = tid + 512 * (i2 + u), tt = cc / 224, c8 = (cc % 224) * 8;
    const int tok = tok0 + tt;
    const uint4 cur = curv[u], prv = prvv[u];
    const u32 cw[4] = {cur.x, cur.y, cur.z, cur.w}, pw[4] = {prv.x, prv.y, prv.z, prv.w};
    float xs[8];
    const float mv[8] = {muA[u].x, muA[u].y, muA[u].z, muA[u].w, muB[u].x, muB[u].y, muB[u].z, muB[u].w};
#pragma unroll
    for (int e = 0; e < 4; ++e) {
      const float c0 = bflo(cw[e]), c1 = bfhi(cw[e]);
      xs[2 * e] = c0 + (bflo(pw[e]) - c0) * mv[2 * e];
      xs[2 * e + 1] = c1 + (bfhi(pw[e]) - c1) * mv[2 * e + 1];
    }
    if (c8 >= 1536) {
      if (c8 < 1600) {
#pragma unroll
        for (int e = 0; e < 8; ++e) xs[e] = tanhf(xs[e]);
      } else if (c8 >= 1664) {
#pragma unroll
        for (int e = 0; e < 8; ++e) xs[e] = sigmoidf_(xs[e]);
      }
    }
    uint4 o; o.x = pk2(xs[0], xs[1]); o.y = pk2(xs[2], xs[3]); o.z = pk2(xs[4], xs[5]); o.w = pk2(xs[6], xs[7]);
    if (c8 < 512) *(uint4*)(oR + (size_t)tok * 512 + c8) = o;
    else if (c8 < 1024) *(uint4*)(oK + (size_t)tok * 512 + (c8 - 512)) = o;
    else if (c8 < 1536) {
      if (l == 0) { *(uint4*)(oV + (size_t)tok * 512 + (c8 - 1024)) = o; *(uint4*)(vf + (size_t)tok * 512 + (c8 - 1024)) = o; }
      else *(uint4*)(XV + tt * PXV + (c8 - 1024)) = o;
    } else if (c8 < 1600) *(uint4*)(XW + tt * PXW + (c8 - 1536)) = o;
    else if (c8 < 1664) *(uint4*)(XA + tt * PXW + (c8 - 1600)) = o;
    else *(uint4*)(XG + tt * PXG + (c8 - 1664)) = o;
  }
  }
  __syncthreads();
  const int c0 = wave * 64;
  f32x16 acc[2];
#define LR_GEMM(XP, PITCH, WOFF, KD)                                                                            \
  {                                                                                                             \
    bf16x8 bqs[(KD) / 16][2];                                                                                   \
    _Pragma("unroll") for (int ks = 0; ks < (KD) / 16; ++ks) _Pragma("unroll") for (int nt = 0; nt < 2; ++nt)   \
      bqs[ks][nt] = *(const bf16x8*)(Wb + (WOFF) + (size_t)(c0 + 32 * nt + r) * (KD) + ks * 16 + h * 8);        \
    __builtin_amdgcn_sched_barrier(0);                                                                          \
    _Pragma("unroll") for (int nt = 0; nt < 2; ++nt) _Pragma("unroll") for (int e = 0; e < 16; ++e) acc[nt][e] = 0.f; \
    _Pragma("unroll") for (int ks = 0; ks < (KD) / 16; ++ks) {                                                   \
      const bf16x8 a = *(const bf16x8*)((XP) + r * (PITCH) + ks * 16 + h * 8);                                    \
      _Pragma("unroll") for (int nt = 0; nt < 2; ++nt)                                                            \
        acc[nt] = __builtin_amdgcn_mfma_f32_32x32x16_bf16(a, bqs[ks][nt], acc[nt], 0, 0, 0);                      \
    }                                                                                                           \
  }
  LR_GEMM(XW, PXW, WO_WUP, 64)
#pragma unroll
  for (int nt = 0; nt < 2; ++nt) {
    const int c = c0 + 32 * nt + r;
    const float w0 = p.in[I_C_W0][l * 512 + c];
#pragma unroll
    for (int e = 0; e < 16; ++e) {
      const int t = (e & 3) + 8 * (e >> 2) + 4 * h;
      oW[(size_t)(tok0 + t) * 512 + c] = f2bf(-softplusf_(-(w0 + acc[nt][e])) - 0.5f);
    }
  }
  LR_GEMM(XA, PXW, WO_AUP, 64)
#pragma unroll
  for (int nt = 0; nt < 2; ++nt) {
    const int c = c0 + 32 * nt + r;
    const float a00 = p.in[I_C_A0][l * 512 + c];
#pragma unroll
    for (int e = 0; e < 16; ++e) {
      const int t = (e & 3) + 8 * (e >> 2) + 4 * h;
      oA[(size_t)(tok0 + t) * 512 + c] = f2bf(sigmoidf_(a00 + acc[nt][e]));
    }
  }
  LR_GEMM(XG, PXG, WO_GUP, 128)
#pragma unroll
  for (int nt = 0; nt < 2; ++nt) {
    const int c = c0 + 32 * nt + r;
#pragma unroll
    for (int e = 0; e < 16; ++e) {
      const int t = (e & 3) + 8 * (e >> 2) + 4 * h;
      oG[(size_t)(tok0 + t) * 512 + c] = f2bf(acc[nt][e]);
    }
  }
  if (l > 0) {
    {
      f32x16 pacc;
#pragma unroll
      for (int e = 0; e < 16; ++e) pacc[e] = 0.f;
#pragma unroll
      for (int ks = 0; ks < 4; ++ks) {
        const bf16x8 a = *(const bf16x8*)(XV + r * PXV + wave * 64 + ks * 16 + h * 8);
        const bf16x8 bq = *(const bf16x8*)(Wb + WO_VDN + (size_t)r * 512 + wave * 64 + ks * 16 + h * 8);
        pacc = __builtin_amdgcn_mfma_f32_32x32x16_bf16(a, bq, pacc, 0, 0, 0);
      }
#pragma unroll
      for (int e = 0; e < 16; ++e) VDP[(wave * 32 + (e & 3) + 8 * (e >> 2) + 4 * h) * 33 + r] = pacc[e];
    }
    __syncthreads();
#pragma unroll
    for (int q = 0; q < 2; ++q) {
      const int o = tid + 512 * q, t = o >> 5, m = o & 31;
      float sm = 0.f;
#pragma unroll
      for (int w8 = 0; w8 < 8; ++w8) sm += VDP[(w8 * 32 + t) * 33 + m];
      XD[t * PXD + m] = f2bf(sm);
    }
    __syncthreads();
#pragma unroll
    for (int nt = 0; nt < 2; ++nt)
#pragma unroll
      for (int e = 0; e < 16; ++e) acc[nt][e] = 0.f;
#pragma unroll
    for (int ks = 0; ks < 2; ++ks) {
      const bf16x8 a = *(const bf16x8*)(XD + r * PXD + ks * 16 + h * 8);
#pragma unroll
      for (int nt = 0; nt < 2; ++nt) {
        const bf16x8 bq = *(const bf16x8*)(Wb + WO_VUP + (size_t)(c0 + 32 * nt + r) * 64 + ks * 16 + h * 8);
        acc[nt] = __builtin_amdgcn_mfma_f32_32x32x16_bf16(a, bq, acc[nt], 0, 0, 0);
      }
    }
    float vfv[2][16];
#pragma unroll
    for (int nt = 0; nt < 2; ++nt)
#pragma unroll
      for (int e = 0; e < 16; ++e) vfv[nt][e] = bf2f(vf[(size_t)(tok0 + (e & 3) + 8 * (e >> 2) + 4 * h) * 512 + c0 + 32 * nt + r]);
    __builtin_amdgcn_sched_barrier(0);
#pragma unroll
    for (int nt = 0; nt < 2; ++nt) {
      const int c = c0 + 32 * nt + r;
      const float v0 = p.in[I_C_V0][(l - 1) * 512 + c];
#pragma unroll
      for (int e = 0; e < 16; ++e) {
        const int t = (e & 3) + 8 * (e >> 2) + 4 * h;
        const float gate = sigmoidf_(v0 + acc[nt][e]);
        const float v = bf2f(XV[t * PXV + c]);
        oV[(size_t)(tok0 + t) * 512 + c] = f2bf(v + (vfv[nt][e] - v) * gate);
      }
    }
  }
#undef LR_GEMM
  __syncthreads();
}
__device__ __forceinline__ void ph_prep(const Params& p, int l, unsigned char* smem, int bid, int nb) {
  for (int it = bid; it < T / 32; it += nb) prep_item(p, l, smem, it);
}

struct FragPtrs { unsigned char* fa; unsigned char* fb; unsigned char* fc; unsigned char* fd; };
__device__ __forceinline__ FragPtrs frag_ptrs(const Params& p, int l) {
  FragPtrs f;
  f.fa = p.ws + 9 * U;
  f.fb = (l == 0) ? (unsigned char*)p.out : p.ws + R_VF;
  f.fc = p.ws + R_W + WO_GU * 2;
  f.fd = p.ws + R_W + WO_IN * 2;
  return f;
}
constexpr int P2P = 72;
__device__ __forceinline__ void prep2_item(const Params& p, int l, const FragPtrs& fp, u16* sw, int rec, int lane) {
  const int bh = rec >> 8, c = rec & 255, b = bh >> 3, hh = bh & 7, cb = hh * 64;
  const int r = lane & 31, h = lane >> 5;
  const size_t tok0 = (size_t)b * S + c * 32;
  const u16* gR = (const u16*)(p.ws + RW_R); const u16* gW = (const u16*)(p.ws + RW_W);
  const u16* gK = (const u16*)(p.ws + RW_K); const u16* gA = (const u16*)(p.ws + RW_A);
  u16* sA = sw; u16* sR = sA + 32 * P2P; u16* sB = sR + 32 * P2P; u16* sK = sB + 32 * P2P;
  const float kkc = p.in[I_C_K_K][l * 512 + cb + lane], kac = p.in[I_C_K_A][l * 512 + cb + lane];
  float G = 0.f;
  {
    const u16* pR = gR + tok0 * 512 + cb + lane; const u16* pW = gW + tok0 * 512 + cb + lane;
    const u16* pK = gK + tok0 * 512 + cb + lane; const u16* pA = gA + tok0 * 512 + cb + lane;
#pragma unroll 1
    for (int t8 = 0; t8 < 32; t8 += 8) {
    u16 raw[8][4];
#pragma unroll
    for (int u = 0; u < 8; ++u) { raw[u][0] = pR[(t8 + u) * 512]; raw[u][1] = pW[(t8 + u) * 512]; raw[u][2] = pK[(t8 + u) * 512]; raw[u][3] = pA[(t8 + u) * 512]; }
    __builtin_amdgcn_sched_barrier(0);
#pragma unroll
    for (int u = 0; u < 8; ++u) {
      const int t = t8 + u;
      const float rv = bf2f(raw[u][0]), wv = bf2f(raw[u][1]), kv = bf2f(raw[u][2]), av = bf2f(raw[u][3]);
      const float ld = -__expf(wv);
      const float Gp = G;
      G += ld;
      const float kr = kv * kkc;
      const float n2 = wave_sum_fast(kr * kr);
      const float kk = kr * __builtin_amdgcn_rsqf(fmaxf(n2, 1e-24f));
      const float beta = kk * av, kp = kv * (1.f + (av - 1.f) * kac);
      const float eG = __expf(G), eGp = __expf(Gp), eGn = __expf(-G);
      sA[t * P2P + lane] = f2bf(-kk * eGp);
      sR[t * P2P + lane] = f2bf(rv * eG);
      sB[t * P2P + lane] = f2bf(beta * eGn);
      sK[t * P2P + lane] = f2bf(kp * eGn);
    }
    }
  }
  const float GL = __expf(G);
  *(float*)(fp.fd + (size_t)rec * 2304 + 2048 + lane * 4) = GL;
  const float GLx = __shfl_xor(GL, 32);
  __builtin_amdgcn_wave_barrier();
  __builtin_amdgcn_s_waitcnt(0xc07f);
  asm volatile("" ::: "memory");
#pragma unroll
  for (int jt = 0; jt < 2; ++jt) {
    const float gl = (jt == h) ? GL : GLx;
#pragma unroll
    for (int ks = 0; ks < 2; ++ks) {
      float vb[8], vk[8];
#pragma unroll
      for (int e = 0; e < 8; ++e) {
        const int t = 16 * ks + 8 * (e >> 2) + 4 * h + (e & 3);
        vb[e] = bf2f(sB[t * P2P + 32 * jt + r]) * gl;
        vk[e] = bf2f(sK[t * P2P + 32 * jt + r]) * gl;
      }
      *(uint4*)(fp.fa + (size_t)rec * 14336 + (8 + jt * 2 + ks) * 1024 + lane * 16) = make_uint4(pk2(vb[0], vb[1]), pk2(vb[2], vb[3]), pk2(vb[4], vb[5]), pk2(vb[6], vb[7]));
      *(uint4*)(fp.fb + (size_t)rec * 4096 + (jt * 2 + ks) * 1024 + lane * 16) = make_uint4(pk2(vk[0], vk[1]), pk2(vk[2], vk[3]), pk2(vk[4], vk[5]), pk2(vk[6], vk[7]));
    }
  }
#pragma unroll
  for (int ks = 0; ks < 4; ++ks) {
    const uint2 a0 = *(const uint2*)(sA + r * P2P + 16 * ks + 4 * h), a1 = *(const uint2*)(sA + r * P2P + 16 * ks + 8 + 4 * h);
    const uint2 r0 = *(const uint2*)(sR + r * P2P + 16 * ks + 4 * h), r1 = *(const uint2*)(sR + r * P2P + 16 * ks + 8 + 4 * h);
    *(uint4*)(fp.fa + (size_t)rec * 14336 + ks * 1024 + lane * 16) = make_uint4(a0.x, a0.y, a1.x, a1.y);
    *(uint4*)(fp.fa + (size_t)rec * 14336 + (4 + ks) * 1024 + lane * 16) = make_uint4(r0.x, r0.y, r1.x, r1.y);
  }
  f32x16 Dab, Dak, Drb, Drk;
#pragma unroll
  for (int e = 0; e < 16; ++e) { Dab[e] = 0.f; Dak[e] = 0.f; Drb[e] = 0.f; Drk[e] = 0.f; }
#pragma unroll
  for (int ks = 0; ks < 4; ++ks) {
    const bf16x8 fb = *(const bf16x8*)(sB + r * P2P + ks * 16 + h * 8);
    const bf16x8 fk = *(const bf16x8*)(sK + r * P2P + ks * 16 + h * 8);
    const bf16x8 fa = *(const bf16x8*)(sA + r * P2P + ks * 16 + h * 8);
    const bf16x8 fr = *(const bf16x8*)(sR + r * P2P + ks * 16 + h * 8);
    Dab = __builtin_amdgcn_mfma_f32_32x32x16_bf16(fb, fa, Dab, 0, 0, 0);
    Dak = __builtin_amdgcn_mfma_f32_32x32x16_bf16(fk, fa, Dak, 0, 0, 0);
    Drb = __builtin_amdgcn_mfma_f32_32x32x16_bf16(fb, fr, Drb, 0, 0, 0);
    Drk = __builtin_amdgcn_mfma_f32_32x32x16_bf16(fk, fr, Drk, 0, 0, 0);
  }
#pragma unroll
  for (int e = 0; e < 16; ++e) {
    const int sI = (e & 3) + 8 * (e >> 2) + 4 * h;
    if (!(sI < r)) { Dab[e] = 0.f; Dak[e] = 0.f; }
    if (!(sI <= r)) { Drb[e] = 0.f; Drk[e] = 0.f; }
  }
#pragma unroll
  for (int ks = 0; ks < 2; ++ks) {
    uint4 w;
    w.x = pk2(Dak[8 * ks + 0], Dak[8 * ks + 1]); w.y = pk2(Dak[8 * ks + 2], Dak[8 * ks + 3]); w.z = pk2(Dak[8 * ks + 4], Dak[8 * ks + 5]); w.w = pk2(Dak[8 * ks + 6], Dak[8 * ks + 7]);
    *(uint4*)(fp.fc + (size_t)rec * 4096 + ks * 1024 + lane * 16) = w;
    w.x = pk2(Drb[8 * ks + 0], Drb[8 * ks + 1]); w.y = pk2(Drb[8 * ks + 2], Drb[8 * ks + 3]); w.z = pk2(Drb[8 * ks + 4], Drb[8 * ks + 5]); w.w = pk2(Drb[8 * ks + 6], Drb[8 * ks + 7]);
    *(uint4*)(fp.fc + (size_t)rec * 4096 + (2 + ks) * 1024 + lane * 16) = w;
    w.x = pk2(Drk[8 * ks + 0], Drk[8 * ks + 1]); w.y = pk2(Drk[8 * ks + 2], Drk[8 * ks + 3]); w.z = pk2(Drk[8 * ks + 4], Drk[8 * ks + 5]); w.w = pk2(Drk[8 * ks + 6], Drk[8 * ks + 7]);
    *(uint4*)(fp.fd + (size_t)rec * 2304 + ks * 1024 + lane * 16) = w;
  }
  __builtin_amdgcn_wave_barrier();
  __builtin_amdgcn_s_waitcnt(0xc07f);
  asm volatile("" ::: "memory");
  float* LT = (float*)sB;
#pragma unroll
  for (int q = 0; q < 4; ++q) *(float4*)(LT + r * 36 + 8 * q + 4 * h) = make_float4(Dab[4 * q], Dab[4 * q + 1], Dab[4 * q + 2], Dab[4 * q + 3]);
  __builtin_amdgcn_wave_barrier();
  __builtin_amdgcn_s_waitcnt(0xc07f);
  asm volatile("" ::: "memory");
  float x[32];
#pragma unroll
  for (int m = 0; m < 32; ++m) x[m] = 0.f;
#pragma unroll
  for (int sI = 31; sI >= 1; --sI) {
    const float xs = x[sI] + ((sI == r) ? 1.f : 0.f);
    x[sI] = xs;
#pragma unroll
    for (int m4 = 0; m4 < sI; m4 += 4) {
      const float4 v = *(const float4*)(LT + sI * 36 + m4);
      x[m4] += v.x * xs; x[m4 + 1] += v.y * xs; x[m4 + 2] += v.z * xs; x[m4 + 3] += v.w * xs;
    }
  }
  x[0] += (r == 0) ? 1.f : 0.f;
#pragma unroll
  for (int ks = 0; ks < 2; ++ks) {
    uint4 w;
    w.x = h ? pk2(x[16 * ks + 4], x[16 * ks + 5]) : pk2(x[16 * ks + 0], x[16 * ks + 1]);
    w.y = h ? pk2(x[16 * ks + 6], x[16 * ks + 7]) : pk2(x[16 * ks + 2], x[16 * ks + 3]);
    w.z = h ? pk2(x[16 * ks + 12], x[16 * ks + 13]) : pk2(x[16 * ks + 8], x[16 * ks + 9]);
    w.w = h ? pk2(x[16 * ks + 14], x[16 * ks + 15]) : pk2(x[16 * ks + 10], x[16 * ks + 11]);
    *(uint4*)(fp.fa + (size_t)rec * 14336 + (12 + ks) * 1024 + lane * 16) = w;
  }
  __builtin_amdgcn_wave_barrier();
  __builtin_amdgcn_s_waitcnt(0xc07f);
  asm volatile("" ::: "memory");
}
__device__ __forceinline__ void ph_prep2(const Params& p, int l, unsigned char* smem, int bid, int nb) {
  const int lane = opaque_tid() & 63, wave = opaque_tid() >> 6;
  const FragPtrs fp = frag_ptrs(p, l);
  u16* sw = (u16*)(smem + wave * (4 * 32 * P2P * 2));
  for (int rec = bid * 8 + wave; rec < 4096; rec += nb * 8) prep2_item(p, l, fp, sw, rec, lane);
}

__device__ __forceinline__ bf16x8 pack8(const f32x16& a, int s2) {
  union { bf16x8 v; u32 w[4]; } cv;
  cv.w[0] = pk2(a[8 * s2 + 0], a[8 * s2 + 1]); cv.w[1] = pk2(a[8 * s2 + 2], a[8 * s2 + 3]);
  cv.w[2] = pk2(a[8 * s2 + 4], a[8 * s2 + 5]); cv.w[3] = pk2(a[8 * s2 + 6], a[8 * s2 + 7]);
  return cv.v;
}
constexpr int SC_SLOT = 24 * 1024 + 256 + 4096, SC_NS = 5;
__device__ __forceinline__ void ph_scan2(const Params& p, int l, unsigned char* smem, int bid, int nb) {
  const int lane = opaque_tid() & 63, wave = __builtin_amdgcn_readfirstlane(opaque_tid() >> 6), r = lane & 31, h = lane >> 5;
  const FragPtrs fp = frag_ptrs(p, l);
  const u16* gV = (const u16*)(p.ws + RW_V);
  u16* gY = (u16*)(p.ws + R_YC);
  for (int bh = bid; bh < 16; bh += nb) {
    const size_t rec0 = (size_t)bh * 256;
    if (wave >= 2) {
      const int lw = wave - 2;
      const size_t tbL = (size_t)(bh >> 3) * S; const int cbL = (bh & 7) * 64;
#define SC_ISSUE(C)                                                                                                              \
      {                                                                                                                          \
        const int cc_ = (C) < 256 ? (C) : 255;                                                                                   \
        unsigned char* slot_ = smem + ((C) % SC_NS) * SC_SLOT;                                                                   \
        const size_t rec_ = rec0 + cc_;                                                                                          \
        _Pragma("unroll") for (int q = 0; q < 4; ++q) {                                                                          \
          const int f = lw * 4 + q;                                                                                              \
          const unsigned char* src_ = f < 14 ? fp.fa + rec_ * 14336 + f * 1024                                                   \
                                    : (f < 18 ? fp.fb + rec_ * 4096 + (f - 14) * 1024                                            \
                                    : (f < 22 ? fp.fc + rec_ * 4096 + (f - 18) * 1024 : fp.fd + rec_ * 2304 + (f - 22) * 1024)); \
          __builtin_amdgcn_global_load_lds((const unsigned*)(src_ + lane * 16), (unsigned*)(slot_ + f * 1024), 16, 0, 0);         \
        }                                                                                                                        \
        if (lw == 5) __builtin_amdgcn_global_load_lds((const unsigned*)(fp.fd + rec_ * 2304 + 2048 + lane * 4), (unsigned*)(slot_ + 24576), 4, 0, 0); \
        if (lw < 4) __builtin_amdgcn_global_load_lds((const unsigned*)(gV + (tbL + cc_ * 32 + lw * 8 + (lane >> 3)) * 512 + cbL + (lane & 7) * 8), (unsigned*)(slot_ + 24832 + lw * 1024), 16, 0, 0); \
      }
      SC_ISSUE(0) SC_ISSUE(1) SC_ISSUE(2) SC_ISSUE(3)
      if (lw == 4) asm volatile("s_waitcnt vmcnt(12)" ::: "memory"); else asm volatile("s_waitcnt vmcnt(15)" ::: "memory");
      __builtin_amdgcn_s_barrier();
#pragma unroll 1
      for (int c = 0; c < 256; ++c) {
        SC_ISSUE(c + 4)
        if (lw == 4) asm volatile("s_waitcnt vmcnt(12)" ::: "memory"); else asm volatile("s_waitcnt vmcnt(15)" ::: "memory");
        __builtin_amdgcn_s_barrier();
      }
      asm volatile("s_waitcnt vmcnt(0)" ::: "memory");
#undef SC_ISSUE
    } else {
      const int it = wave;
      const int b = bh >> 3, hh = bh & 7, cb = hh * 64;
      const size_t tb = (size_t)b * S;
      const int voff = (4 * h) * 512 + r;
      f32x16 ST[2];
#pragma unroll
      for (int jt = 0; jt < 2; ++jt)
#pragma unroll
        for (int e = 0; e < 16; ++e) ST[jt][e] = 0.f;
      asm volatile("s_waitcnt lgkmcnt(0)" ::: "memory");
      __builtin_amdgcn_s_barrier();
#pragma unroll 1
      for (int c = 0; c < 256; ++c) {
        const unsigned char* slot = smem + (c % SC_NS) * SC_SLOT;
#define FR_(f) (*(const bf16x8*)(slot + (f) * 1024 + lane * 16))
        bf16x8 fA[10];
#pragma unroll
        for (int ks = 0; ks < 4; ++ks) { fA[ks] = FR_(ks); fA[6 + ks] = FR_(4 + ks); }
#pragma unroll
        for (int ks = 0; ks < 2; ++ks) fA[4 + ks] = FR_(18 + ks);
        float4 gm[2][4];
#pragma unroll
        for (int jt = 0; jt < 2; ++jt)
#pragma unroll
          for (int q = 0; q < 4; ++q) gm[jt][q] = *(const float4*)(slot + 24576 + (32 * jt + 8 * q + 4 * h) * 4);
        __builtin_amdgcn_sched_barrier(0);
        bf16x8 fB[14];
#pragma unroll
        for (int ks = 0; ks < 2; ++ks) fB[ks] = FR_(12 + ks);
#pragma unroll
        for (int q = 0; q < 4; ++q) { fB[2 + q] = FR_(8 + q); fB[6 + q] = FR_(14 + q); }
        bf16x8 Vf[2];
        {
          const u16* vt = (const u16*)(slot + 24832) + 32 * it + r;
#pragma unroll
          for (int ks = 0; ks < 2; ++ks) {
            union { bf16x8 v; u16 e[8]; } cv;
#pragma unroll
            for (int e = 0; e < 8; ++e) cv.e[e] = vt[(16 * ks + 8 * (e >> 2) + 4 * h + (e & 3)) * 64];
            Vf[ks] = cv.v;
          }
        }
        __builtin_amdgcn_sched_barrier(0);
        bf16x8 stb[4];
#pragma unroll
        for (int ks = 0; ks < 4; ++ks) stb[ks] = pack8(ST[ks >> 1], ks & 1);
        f32x16 N[2];
#pragma unroll
        for (int jt = 0; jt < 2; ++jt)
#pragma unroll
          for (int q = 0; q < 4; ++q) {
            N[jt][4 * q + 0] = ST[jt][4 * q + 0] * gm[jt][q].x; N[jt][4 * q + 1] = ST[jt][4 * q + 1] * gm[jt][q].y;
            N[jt][4 * q + 2] = ST[jt][4 * q + 2] * gm[jt][q].z; N[jt][4 * q + 3] = ST[jt][4 * q + 3] * gm[jt][q].w;
          }
        f32x16 X1;
#pragma unroll
        for (int e = 0; e < 16; ++e) X1[e] = 0.f;
#pragma unroll
        for (int ks = 0; ks < 4; ++ks) X1 = __builtin_amdgcn_mfma_f32_32x32x16_bf16(fA[ks], stb[ks], X1, 0, 0, 0);
#pragma unroll
        for (int ks = 0; ks < 2; ++ks) X1 = __builtin_amdgcn_mfma_f32_32x32x16_bf16(fA[4 + ks], Vf[ks], X1, 0, 0, 0);
        f32x16 Y;
#pragma unroll
        for (int e = 0; e < 16; ++e) Y[e] = 0.f;
#pragma unroll
        for (int ks = 0; ks < 4; ++ks) Y = __builtin_amdgcn_mfma_f32_32x32x16_bf16(fA[6 + ks], stb[ks], Y, 0, 0, 0);
        f32x16 Ut;
#pragma unroll
        for (int e = 0; e < 16; ++e) Ut[e] = 0.f;
#pragma unroll
        for (int ks = 0; ks < 2; ++ks) Ut = __builtin_amdgcn_mfma_f32_32x32x16_bf16(fB[ks], pack8(X1, ks), Ut, 0, 0, 0);
        __builtin_amdgcn_sched_barrier(0);
#pragma unroll
        for (int ks = 0; ks < 2; ++ks) { fB[10 + ks] = FR_(20 + ks); fB[12 + ks] = FR_(22 + ks); }
        __builtin_amdgcn_sched_barrier(0);
        bf16x8 utb[2];
#pragma unroll
        for (int ks = 0; ks < 2; ++ks) utb[ks] = pack8(Ut, ks);
#pragma unroll
        for (int jt = 0; jt < 2; ++jt) {
#pragma unroll
          for (int ks = 0; ks < 2; ++ks) N[jt] = __builtin_amdgcn_mfma_f32_32x32x16_bf16(fB[2 + jt * 2 + ks], utb[ks], N[jt], 0, 0, 0);
#pragma unroll
          for (int ks = 0; ks < 2; ++ks) N[jt] = __builtin_amdgcn_mfma_f32_32x32x16_bf16(fB[6 + jt * 2 + ks], Vf[ks], N[jt], 0, 0, 0);
        }
#pragma unroll
        for (int ks = 0; ks < 2; ++ks) Y = __builtin_amdgcn_mfma_f32_32x32x16_bf16(fB[10 + ks], utb[ks], Y, 0, 0, 0);
#pragma unroll
        for (int ks = 0; ks < 2; ++ks) Y = __builtin_amdgcn_mfma_f32_32x32x16_bf16(fB[12 + ks], Vf[ks], Y, 0, 0, 0);
        ST[0] = N[0]; ST[1] = N[1];
#pragma unroll
        for (int e = 0; e < 16; ++e) {
          u16* yb_ = gY + (tb + c * 32 + 8 * (e >> 2)) * 512 + cb + 32 * it;
          yb_[voff + (e & 3) * 512] = f2bf(Y[e]);
        }
        asm volatile("s_waitcnt lgkmcnt(0)" ::: "memory");
        __builtin_amdgcn_s_barrier();
#undef FR_
      }
    }
  }
}

__device__ __forceinline__ void ph_post(const Params& p, int l, const float* xin, int bid, int nb) {
  const int lane = opaque_tid() & 63, wave = opaque_tid() >> 6;
  ph_rmsnorm(xin, p.in[I_NORM_MIX] + l * 1024, (u16*)(p.ws + R_H2), nullptr, bid * 8 + wave, nb * 8);
  const u16* gR = (const u16*)(p.ws + RW_R); const u16* gK = (const u16*)(p.ws + RW_K);
  const u16* gV = (const u16*)(p.ws + RW_V); const u16* gA = (const u16*)(p.ws + RW_A); const u16* gG = (const u16*)(p.ws + RW_G);
  u16* gY = (u16*)(p.ws + R_YC);
  const int gw = bid * 8 + wave, hh = gw & 7, c = hh * 64 + lane;
  const float cka = p.in[I_C_K_A][l * 512 + c], crk = p.in[I_C_R_K][l * 512 + c];
  const float clg = p.in[I_C_LNX_G][l * 512 + c], clb = p.in[I_C_LNX_B][l * 512 + c];
  const int ngw = nb * 8;
  for (int it0 = gw; it0 < T * 8; it0 += 4 * ngw) {
    float y[4], rv[4], kv[4], vv[4], av[4], gv[4];
    u16 raw[4][6];
#pragma unroll
    for (int u = 0; u < 4; ++u) {
      const int it = it0 + u * ngw;
      const size_t idx = (size_t)((it < T * 8 ? it : gw) >> 3) * 512 + c;
      raw[u][0] = gY[idx]; raw[u][1] = gR[idx]; raw[u][2] = gK[idx]; raw[u][3] = gV[idx]; raw[u][4] = gA[idx]; raw[u][5] = gG[idx];
    }
    __builtin_amdgcn_sched_barrier(0);
#pragma unroll
    for (int u = 0; u < 4; ++u) {
      y[u] = bf2f(raw[u][0]); rv[u] = bf2f(raw[u][1]); kv[u] = bf2f(raw[u][2]); vv[u] = bf2f(raw[u][3]); av[u] = bf2f(raw[u][4]); gv[u] = bf2f(raw[u][5]);
    }
#pragma unroll
    for (int u = 0; u < 4; ++u) {
      const int it = it0 + u * ngw;
      const float mu = wave_sum_fast(y[u]) * (1.f / 64.f);
      const float dv = y[u] - mu;
      const float var = wave_sum_fast(dv * dv) * (1.f / 64.f);
      const float kp = kv[u] * (1.f + (av[u] - 1.f) * cka);
      const float bonus = wave_sum_fast(rv[u] * kp * crk);
      float o = dv * rsqrtf(var + 64e-5f) * clg + clb;
      o = (o + bonus * vv[u]) * gv[u];
      if (it < T * 8) gY[(size_t)(it >> 3) * 512 + c] = f2bf(o);
    }
  }
}

__device__ __forceinline__ void ph_merge(const Params& p, int l, unsigned char* smem, int bid, int nb) {
  const u16* H2 = (const u16*)(p.ws + R_H2);
  const u16* Wb = (const u16*)(p.ws + R_W);
  u16* Mg = (u16*)(p.ws + R_MERGED);
  const int lane = opaque_tid() & 63, wave = opaque_tid() >> 6, wm = wave >> 1, wn = wave & 1, r = lane & 31, h = lane >> 5;
  bool pf = false;
  for (int t = bid; t < 64 * 8; t += nb) {
    int mt, nt; tile_decode(t, 8, mt, nt);
    const int m0 = mt * 256, n0 = nt * 128;
    f32x16 out[2][2]; acc_zero(out);
#pragma unroll 1
    for (int br = 0; br < 3; ++br) {
      f32x16 acc[2][2]; acc_zero(acc);
      gemm_kloop(H2 + (size_t)m0 * 1024, 1024, Wb + WO_IN + (size_t)(NMIX + br * 1024 + n0) * 1024, 1024, 1024, acc, (u16*)smem, pf, false);
      const u16* Y; const u16* P; int K;
      if (br == 0) { Y = (const u16*)(p.ws + R_UA) + (size_t)m0 * 1024; P = Wb + WO_PA + (size_t)n0 * 1024; K = 1024; }
      else if (br == 1) { Y = (const u16*)(p.ws + R_YB) + (size_t)m0 * 512; P = Wb + WO_PB + (size_t)n0 * 512; K = 512; }
      else { Y = (const u16*)(p.ws + R_YC) + (size_t)m0 * 512; P = Wb + WO_PC + (size_t)n0 * 512; K = 512; }
      gemm_prefetch(Y, K, P, K, K, (u16*)smem);
      const float* gb = p.in[I_GATE_BIAS] + (size_t)(l * 3 + br) * 1024 + n0 + wn * 64 + r;
      u32 gpk[2][2][8];
#pragma unroll
      for (int i = 0; i < 2; ++i)
#pragma unroll
        for (int j = 0; j < 2; ++j) {
          const float bj = gb[j * 32];
#pragma unroll
          for (int e = 0; e < 8; ++e) gpk[i][j][e] = pk2(sigmoidf_(acc[i][j][2 * e] + bj), sigmoidf_(acc[i][j][2 * e + 1] + bj));
        }
      acc_zero(acc);
      gemm_kloop(Y, K, P, K, K, acc, (u16*)smem, true, false);
      pf = true;
      if (br < 2) {
        gemm_prefetch(H2 + (size_t)m0 * 1024, 1024, Wb + WO_IN + (size_t)(NMIX + (br + 1) * 1024 + n0) * 1024, 1024, 1024, (u16*)smem);
      } else if (t + nb < 64 * 8) {
        int mt2, nt2; tile_decode(t + nb, 8, mt2, nt2);
        gemm_prefetch(H2 + (size_t)mt2 * 256 * 1024, 1024, Wb + WO_IN + (size_t)(NMIX + nt2 * 128) * 1024, 1024, 1024, (u16*)smem);
      } else pf = false;
#pragma unroll
      for (int i = 0; i < 2; ++i)
#pragma unroll
        for (int j = 0; j < 2; ++j)
#pragma unroll
          for (int e = 0; e < 8; ++e) {
            out[i][j][2 * e] += bflo(gpk[i][j][e]) * acc[i][j][2 * e];
            out[i][j][2 * e + 1] += bfhi(gpk[i][j][e]) * acc[i][j][2 * e + 1];
          }
    }
    EPI_LOOP(i, j, e) {
      const int m = m0 + wm * 64 + i * 32 + (e & 3) + 8 * (e >> 2) + 4 * h;
      Mg[(size_t)m * 1024 + n0 + wn * 64 + j * 32 + r] = f2bf(out[i][j][e]);
    }
  }
}

__device__ __forceinline__ void ph_resgemm(const u16* A, int K, const u16* Wt, const float* xin, float* xr, unsigned char* smem, int bid, int nb) {
  const int lane = opaque_tid() & 63, wave = opaque_tid() >> 6, wm = wave >> 1, wn = wave & 1, r = lane & 31, h = lane >> 5;
  bool pf = false;
  for (int t = bid; t < 64 * 8; t += nb) {
    int mt, nt; tile_decode(t, 8, mt, nt);
    const int m0 = mt * 256, n0 = nt * 128;
    f32x16 acc[2][2]; acc_zero(acc);
    gemm_kloop(A + (size_t)m0 * K, K, Wt + (size_t)n0 * K, K, K, acc, (u16*)smem, pf);
    pf = (t + nb < 64 * 8);
    if (pf) { int mt2, nt2; tile_decode(t + nb, 8, mt2, nt2); gemm_prefetch(A + (size_t)mt2 * 256 * K, K, Wt + (size_t)nt2 * 128 * K, K, K, (u16*)smem); }
#pragma unroll
    for (int i = 0; i < 2; ++i) {
      float tv[2][16];
#pragma unroll
      for (int j = 0; j < 2; ++j)
#pragma unroll
        for (int e = 0; e < 16; ++e) {
          const int m = m0 + wm * 64 + i * 32 + (e & 3) + 8 * (e >> 2) + 4 * h;
          tv[j][e] = xin[(size_t)m * 1024 + n0 + wn * 64 + j * 32 + r];
        }
      __builtin_amdgcn_sched_barrier(0);
#pragma unroll
      for (int j = 0; j < 2; ++j)
#pragma unroll
        for (int e = 0; e < 16; ++e) {
          const int m = m0 + wm * 64 + i * 32 + (e & 3) + 8 * (e >> 2) + 4 * h;
          xr[(size_t)m * 1024 + n0 + wn * 64 + j * 32 + r] = acc[i][j][e] + tv[j][e];
        }
      __builtin_amdgcn_sched_barrier(0);
    }
  }
}

__device__ __forceinline__ void ph_ffnup(const Params& p, unsigned char* smem, int bid, int nb) {
  const u16* Hf = (const u16*)(p.ws + R_HF);
  const u16* Wt = (const u16*)(p.ws + R_W) + WO_GU;
  u16* act = (u16*)(p.ws + R_ACT);
  const int lane = opaque_tid() & 63, wave = opaque_tid() >> 6, wm = wave >> 1, wn = wave & 1, r = lane & 31, h = lane >> 5;
  constexpr int NT = 5632 / 128;
  bool pf = false;
  for (int t = bid; t < 64 * NT; t += nb) {
    int mt, nt; tile_decode(t, NT, mt, nt);
    const int m0 = mt * 256, n0 = nt * 128;
    f32x16 acc[2][2]; acc_zero(acc);
    gemm_kloop(Hf + (size_t)m0 * 1024, 1024, Wt + (size_t)n0 * 1024, 1024, 1024, acc, (u16*)smem, pf);
    pf = (t + nb < 64 * NT);
    if (pf) { int mt2, nt2; tile_decode(t + nb, NT, mt2, nt2); gemm_prefetch(Hf + (size_t)mt2 * 256 * 1024, 1024, Wt + (size_t)nt2 * 128 * 1024, 1024, 1024, (u16*)smem); }
    const int col = ((n0 + wn * 64) >> 6) * 32 + r;
#pragma unroll
    for (int i = 0; i < 2; ++i)
#pragma unroll
      for (int e = 0; e < 16; ++e) {
        const int m = m0 + wm * 64 + i * 32 + (e & 3) + 8 * (e >> 2) + 4 * h;
        const float gt = acc[i][0][e], up = acc[i][1][e];
        act[(size_t)m * DFF + col] = f2bf(gt * sigmoidf_(gt) * up);
      }
  }
}

#define XB_XCNT(j)  (256  + 64 * (j))
#define XB_XSUB(j)  (1280 + 64 * (j))
#define XB_XGEN(j)  (2304 + 64 * (j))
#define XB_TOP      3328
#define XB_TOPGEN   3392
#define XCD_BAR_WORDS 3456
__device__ __forceinline__ unsigned xb_ld(unsigned* q) { return __hip_atomic_load(q, __ATOMIC_RELAXED, __HIP_MEMORY_SCOPE_AGENT); }
__device__ __forceinline__ unsigned xb_add(unsigned* q, unsigned v) { return __hip_atomic_fetch_add(q, v, __ATOMIC_RELAXED, __HIP_MEMORY_SCOPE_AGENT); }
__device__ __forceinline__ unsigned xb_xcc_id() { return (unsigned)__builtin_amdgcn_s_getreg((3 << 11) | 20) & 0xFu; }
__device__ __forceinline__ void xcd_grid_barrier(unsigned* bar, volatile unsigned* st, unsigned xcc, unsigned G) {
  asm volatile("s_waitcnt vmcnt(0)" ::: "memory");
  __syncthreads();
  if (opaque_tid() == 0) {
    __builtin_amdgcn_s_waitcnt(0);
    unsigned nloc = st[0], nx = st[1];
    if (nloc == 0u) {
      for (;;) {
        unsigned sum = 0u, cnt = 0u, mine = 0u;
#pragma unroll
        for (unsigned j = 0; j < 16; ++j) { const unsigned c = xb_ld(&bar[XB_XCNT(j)]); sum += c; cnt += (c > 0u) ? 1u : 0u; mine = (j == xcc) ? c : mine; }
        if (sum == G) { nloc = mine; nx = cnt; break; }
        __builtin_amdgcn_s_sleep(1);
      }
      st[0] = nloc; st[1] = nx;
    }
    const unsigned old = xb_add(&bar[XB_XSUB(xcc)], 1u);
    const unsigned gen = old / nloc;
    if (old + 1u == (gen + 1u) * nloc) {
      __builtin_amdgcn_fence(__ATOMIC_RELEASE, "agent");
      asm volatile("s_waitcnt vmcnt(0)" ::: "memory");
      const unsigned og = xb_add(&bar[XB_TOP], 1u);
      const unsigned tg = og / nx;
      if (og + 1u == (tg + 1u) * nx) xb_add(&bar[XB_TOPGEN], 1u);
      else while (xb_ld(&bar[XB_TOPGEN]) == tg) __builtin_amdgcn_s_sleep(1);
      __builtin_amdgcn_fence(__ATOMIC_ACQUIRE, "agent");
      xb_add(&bar[XB_XGEN(xcc)], 1u);
      asm volatile("s_waitcnt vmcnt(0)" ::: "memory");
    } else {
      while (xb_ld(&bar[XB_XGEN(xcc)]) == gen) __builtin_amdgcn_s_sleep(1);
      __builtin_amdgcn_fence(__ATOMIC_ACQUIRE, "agent");
      asm volatile("s_waitcnt vmcnt(0)" ::: "memory");
    }
  }
  __syncthreads();
}
#ifndef ONLY
#define ONLY -1
#endif
#define PH_ON(q) (ONLY < 0 || ONLY == (q))
constexpr int PH_PER_LAYER = 13;
constexpr int N_PHASES = 2 * PH_PER_LAYER + 1;

__global__ void __launch_bounds__(NTHR) fwd_kernel(Params p) {
  extern __shared__ __attribute__((aligned(16))) unsigned char smem[];
  const int bid = blockIdx.x, nb = gridDim.x;
  __shared__ unsigned xb_st[4];
  unsigned* xbar = (unsigned*)(p.ws + WS_CTR);
  const unsigned xcc = xb_xcc_id();
  if (opaque_tid() == 0) { xb_st[0] = 0u; xb_st[1] = 0u; (void)xb_add(&xbar[XB_XCNT(xcc)], 1u); }
  __syncthreads();
  for (int pi = 0; pi < p.nph; ++pi) {
    if (pi == 1) { cg::this_grid().sync(); }
    else if (pi > 1) { xcd_grid_barrier(xbar, xb_st, xcc, (unsigned)nb); }
    const int wave = opaque_tid() >> 6;
    const unsigned long long cw = pi < 12 ? p.code[0] : (pi < 24 ? p.code[1] : (pi < 36 ? p.code[2] : p.code[3]));
    const int pc_ = (int)((cw >> (5 * (pi % 12))) & 31);
    if (pc_ == 27) continue;
    if (pc_ == 26) {
      ph_rmsnorm(p.out, p.in[I_NORM_FINAL], nullptr, p.out, bid * 8 + wave, nb * 8);
      continue;
    }
    const int l = pc_ / PH_PER_LAYER, q = pc_ % PH_PER_LAYER;
    const float* xin = (l == 0) ? p.in[I_X] : p.out;
    switch (q) {
      case 0:
        if (PH_ON(0)) {
          ph_convert(p, l, smem, bid, nb, 0);
          ph_rmsnorm(xin, p.in[I_NORM_MIX] + l * 1024, (u16*)(p.ws + R_H), nullptr, bid * 8 + wave, nb * 8);
        }
        break;
      case 1: if (PH_ON(1)) { ph_inproj(p, l, smem, bid, nb); } break;
      case 2: if (PH_ON(2)) { ph_mixerA(p, l, smem, bid, nb); } break;
      case 3: if (PH_ON(3)) { ph_attn(p, l, smem, bid, nb); } break;
      case 4: if (PH_ON(4)) { ph_prep(p, l, smem, bid, nb); } break;
      case 5: if (PH_ON(5)) { ph_prep2(p, l, smem, bid, nb); } break;
      case 6: if (PH_ON(6)) { ph_scan2(p, l, smem, bid, nb); } break;
      case 7: if (PH_ON(7)) { ph_post(p, l, xin, bid, nb); } break;
      case 8: if (PH_ON(8)) { ph_merge(p, l, smem, bid, nb); } break;
      case 9: if (PH_ON(9)) { ph_resgemm((const u16*)(p.ws + R_MERGED), 1024, (const u16*)(p.ws + R_W) + WO_OUT, xin, p.out, smem, bid, nb); } break;
      case 10:
        if (PH_ON(10)) {
          ph_convert(p, l, smem, bid, nb, 1);
          ph_rmsnorm(p.out, p.in[I_NORM_FFN] + l * 1024, (u16*)(p.ws + R_HF), nullptr, bid * 8 + wave, nb * 8);
        }
        break;
      case 11: if (PH_ON(11)) { ph_ffnup(p, smem, bid, nb); } break;
      case 12: if (PH_ON(12)) { ph_resgemm((const u16*)(p.ws + R_ACT), DFF, (const u16*)(p.ws + R_W) + WO_DN, p.out, p.out, smem, bid, nb); } break;
    }
  }
}

extern "C" void kernel_launch(void* const* d_in, const int* in_sizes, int n_in, void* d_out, int out_size, void* d_ws, size_t ws_size,
                              hipStream_t stream) {
  static int grid = 0;
  if (grid == 0) {
    if (n_in != 31 || ws_size < WS_END) { fprintf(stderr, "kernel_launch: unexpected n_in %d / ws_size %zu (need %zu)\n", n_in, ws_size, (size_t)WS_END); grid = -1; return; }
    int dev = 0, cus = 0, per_cu = 0;
    hipGetDevice(&dev);
    hipDeviceGetAttribute(&cus, hipDeviceAttributeMultiprocessorCount, dev);
    hipFuncSetAttribute((const void*)fwd_kernel, hipFuncAttributeMaxDynamicSharedMemorySize, LDS_BYTES);
    hipOccupancyMaxActiveBlocksPerMultiprocessor(&per_cu, (const void*)fwd_kernel, NTHR, LDS_BYTES);
    if (per_cu < 1) per_cu = 1;
    grid = cus * per_cu;
    if (grid > 256) grid = 256;
  }
  if (grid < 0) return;
  Params p{};
  for (int i = 0; i < 31; ++i) p.in[i] = (const float*)d_in[i];
  p.out = (float*)d_out; p.ws = (unsigned char*)d_ws;
  {
    int list[48]; int n = 0;
    for (int ph = 0; ph < N_PHASES; ++ph) {
      list[n++] = ph;
#ifdef REPQ
      if (ph < N_PHASES - 1 && (ph % PH_PER_LAYER) == REPQ) list[n++] = ph;
#endif
    }
#ifdef REPSYNC
    for (int i = 0; i < REPSYNC; ++i) list[n++] = 27;
#endif
    for (int i = 0; i < n; ++i) p.code[i / 12] |= (unsigned long long)list[i] << (5 * (i % 12));
    p.nph = n;
  }
  (void)hipMemsetAsync((unsigned char*)d_ws + WS_CTR, 0, 16384, stream);
  void* args[] = {&p};
  hipError_t e = hipLaunchCooperativeKernel((const void*)fwd_kernel, dim3(grid), dim3(NTHR), args, LDS_BYTES, stream);
  if (e != hipSuccess) fprintf(stderr, "cooperative launch failed: %s (grid %d)\n", hipGetErrorString(e), grid);
}
```
